# Optimizing an MI355X kernel written in HIP

```python
import math
import jax, jax.numpy as jnp
from jax import lax
import numpy as np

D_MODEL = 2048
BATCH = 4
SEQ = 4096
DEPTH = 1

PLE_DIM = 256
ROPE_THETA = 500000.0
ROPE_FRACTION = 4
Q_BLOCK = 128
NORM_EPS = 1e-6
NEG_INF = -1e30

DIFF_HEADS = 8
DIFF_SUB_DIM = 64
DIFF_V_DIM = 2 * DIFF_SUB_DIM
NSA_HEADS = 16
NSA_KV_GROUPS = 2
NSA_GROUP_SIZE = NSA_HEADS // NSA_KV_GROUPS
NSA_HEAD_DIM = 64
CMP_BLOCK = 32
CMP_STRIDE = 16
CMP_HIDDEN = 256
SLC_BLOCK = 64
SLC_TOP_N = 16
SLC_FORCED_BONUS = 1e4
WINDOW = 512
D_FF = 4 * D_MODEL

DIFF_W = DIFF_HEADS * DIFF_V_DIM
NSA_W = NSA_HEADS * NSA_HEAD_DIM
NSA_KV_W = NSA_KV_GROUPS * NSA_HEAD_DIM
IN_SIZES = (DIFF_W, DIFF_W, DIFF_W,
            NSA_W,
            NSA_KV_W, NSA_KV_W,
            NSA_KV_W, NSA_KV_W,
            NSA_KV_W, NSA_KV_W,
            3 * NSA_HEADS,
            D_MODEL, D_MODEL)
IN_W = 3 * DIFF_W + NSA_W + 6 * NSA_KV_W + 3 * NSA_HEADS + 2 * D_MODEL

kernel_name = 'hybrid_diffattn_nsa_sqrelu_ple'


def rms_norm(x, g=None):
    xf = x.astype(jnp.float32)
    y = xf * lax.rsqrt(jnp.mean(xf * xf, axis=-1, keepdims=True) + NORM_EPS)
    if g is not None:
        y = y * g.astype(jnp.float32)
    return y.astype(x.dtype)


def rope_tables(positions, rot_dim):
    inv_freq = jnp.power(ROPE_THETA, -jnp.arange(0, rot_dim, 2, dtype=jnp.float32) / rot_dim)
    ang = positions.astype(jnp.float32)[..., None] * inv_freq
    return jnp.cos(ang), jnp.sin(ang)


def apply_partial_rope(x, cos, sin):
    half = cos.shape[-1]
    r = 2 * half
    x1 = x[..., :half].astype(jnp.float32)
    x2 = x[..., half:r].astype(jnp.float32)
    c = cos[:, :, None, :]
    s = sin[:, :, None, :]
    rot = jnp.concatenate([x1 * c - x2 * s, x2 * c + x1 * s], axis=-1).astype(x.dtype)
    return jnp.concatenate([rot, x[..., r:]], axis=-1)


def masked_softmax(s, mask, axis=-1):
    p = jax.nn.softmax(jnp.where(mask, s, NEG_INF), axis=axis)
    return p * mask


def to_blocks(a):
    b, s = a.shape[:2]
    return jnp.moveaxis(a.reshape((b, s // Q_BLOCK, Q_BLOCK) + a.shape[2:]), 1, 0)


def from_blocks(a):
    a = jnp.moveaxis(a, 0, 1)
    return a.reshape((a.shape[0], a.shape[1] * a.shape[2]) + a.shape[3:])


def split_cols(z, sizes):
    outs, off = [], 0
    for size in sizes:
        outs.append(z[..., off:off + size])
        off += size
    return outs


def diff_attention(q, k, v, lam, lambda_init, subln_g):
    b, s = q.shape[:2]
    scale = DIFF_SUB_DIM ** -0.5
    key_pos = jnp.arange(s)
    vf = v.astype(jnp.float32)

    def block(args):
        qb, bi = args
        sc = jnp.einsum('bqhcd,bkhcd->bhcqk', qb, k,
                        preferred_element_type=jnp.float32) * scale
        q_pos = bi * Q_BLOCK + jnp.arange(Q_BLOCK)
        mask = key_pos[None, :] <= q_pos[:, None]
        prob = masked_softmax(sc, mask)
        attn = prob[:, :, 0] - lam * prob[:, :, 1]
        o = jnp.einsum('bhqk,bkhd->bqhd', attn, vf)
        o = rms_norm(o, subln_g) * (1.0 - lambda_init)
        return o.astype(v.dtype)

    out = lax.map(block, (to_blocks(q), jnp.arange(s // Q_BLOCK)))
    return from_blocks(out).reshape(b, s, DIFF_W)


def compress_tokens(kv, pos_emb, w1, w2):
    b, s, g, d = kv.shape
    n_cmp = (s - CMP_BLOCK) // CMP_STRIDE + 1
    idx = np.arange(n_cmp)[:, None] * CMP_STRIDE + np.arange(CMP_BLOCK)[None, :]
    blocks = kv[:, idx] + pos_emb[:, None, :]
    blocks = blocks.transpose(0, 1, 3, 2, 4).reshape(b, n_cmp, g, CMP_BLOCK * d)
    return jax.nn.gelu(blocks @ w1) @ w2


def nsa_attention(q_rot, q_plain, kc, vc, ks, vs, kw, vw, gates):
    b, s, g, r, d = q_rot.shape
    n_cmp = kc.shape[1]
    n_sel = s // SLC_BLOCK
    top_n = min(SLC_TOP_N, n_sel)
    scale = NSA_HEAD_DIM ** -0.5
    cmp_end = jnp.arange(n_cmp) * CMP_STRIDE + CMP_BLOCK - 1
    cs = np.arange(n_cmp) * CMP_STRIDE
    ss = np.arange(n_sel) * SLC_BLOCK
    overlap = jnp.asarray(((cs[:, None] < ss[None, :] + SLC_BLOCK) &
                           (cs[:, None] + CMP_BLOCK > ss[None, :])).astype(np.float32))
    vc_f = vc.astype(jnp.float32)
    ks_blocks = ks.reshape(b, n_sel, SLC_BLOCK, g, d).transpose(0, 3, 1, 2, 4)
    vs_blocks = vs.astype(jnp.float32).reshape(b, n_sel, SLC_BLOCK, g, d).transpose(0, 3, 1, 2, 4)
    kw_pad = jnp.pad(kw, ((0, 0), (WINDOW, 0), (0, 0), (0, 0)))
    vw_pad = jnp.pad(vw.astype(jnp.float32), ((0, 0), (WINDOW, 0), (0, 0), (0, 0)))
    b_ix = jnp.arange(b)[:, None, None, None]
    g_ix = jnp.arange(g)[None, :, None, None]
    sel_j = jnp.arange(n_sel)

    def block(args):
        qr, qp, gb, bi = args
        q_pos = bi * Q_BLOCK + jnp.arange(Q_BLOCK)
        s_c = jnp.einsum('bqgrd,bngd->bgrqn', qp, kc,
                         preferred_element_type=jnp.float32) * scale
        p_c = masked_softmax(s_c, cmp_end[None, :] <= q_pos[:, None])
        o_c = jnp.einsum('bgrqn,bngd->bqgrd', p_c, vc_f)
        imp = jnp.einsum('bgrqn,nj->bgqj', p_c, overlap)
        q_blk = q_pos // SLC_BLOCK
        valid = sel_j[None, :] <= q_blk[:, None]
        forced = ((sel_j[None, :] == 0) | (sel_j[None, :] == q_blk[:, None]) |
                  (sel_j[None, :] == q_blk[:, None] - 1))
        score = jnp.where(valid, imp + SLC_FORCED_BONUS * forced, -1.0)
        _, sel = lax.top_k(score, top_n)
        k_sel = ks_blocks[b_ix, g_ix, sel]
        v_sel = vs_blocks[b_ix, g_ix, sel]
        s_s = jnp.einsum('bqgrd,bgqtkd->bgrqtk', qr, k_sel,
                         preferred_element_type=jnp.float32) * scale
        sel_pos = sel[..., None] * SLC_BLOCK + jnp.arange(SLC_BLOCK)
        m_s = (sel_pos <= q_pos[None, None, :, None, None])[:, :, None]
        p_s = masked_softmax(s_s, m_s, axis=(-2, -1))
        o_s = jnp.einsum('bgrqtk,bgqtkd->bqgrd', p_s, v_sel)
        start = bi * Q_BLOCK
        k_win = lax.dynamic_slice_in_dim(kw_pad, start, WINDOW + Q_BLOCK, axis=1)
        v_win = lax.dynamic_slice_in_dim(vw_pad, start, WINDOW + Q_BLOCK, axis=1)
        win_pos = start - WINDOW + jnp.arange(WINDOW + Q_BLOCK)
        dist = q_pos[:, None] - win_pos[None, :]
        m_w = (dist >= 0) & (dist < WINDOW) & (win_pos[None, :] >= 0)
        s_w = jnp.einsum('bqgrd,bkgd->bgrqk', qr, k_win,
                         preferred_element_type=jnp.float32) * scale
        p_w = masked_softmax(s_w, m_w)
        o_w = jnp.einsum('bgrqk,bkgd->bqgrd', p_w, v_win)
        gf = gb.astype(jnp.float32)
        o = gf[..., 0:1] * o_c + gf[..., 1:2] * o_s + gf[..., 2:3] * o_w
        return o.astype(q_rot.dtype)

    out = lax.map(block, (to_blocks(q_rot), to_blocks(q_plain), to_blocks(gates),
                          jnp.arange(s // Q_BLOCK)))
    return from_blocks(out).reshape(b, s, NSA_W)


def hybrid_layer(x, p_i, cos, sin, lambda_init, norm_mix, w_in, diff_q_norm, diff_k_norm,
                 diff_lambda, diff_subln, nsa_q_norm, nsa_k_norm, cmp_pos, cmp_w1, cmp_w2,
                 w_proj_diff, w_proj_nsa, w_out, norm_mlp, w_mlp_up, w_mlp_down,
                 w_ple_proj, norm_ple, w_ple_gate):
    b, s, _ = x.shape
    h = rms_norm(x, norm_mix)
    z = h @ w_in
    (dq, dk, dv, nq, kc_r, vc_r, ks_r, vs_r, kw_r, vw_r,
     ng, g_a, g_b) = split_cols(z, IN_SIZES)

    dq = rms_norm(dq.reshape(b, s, 2 * DIFF_HEADS, DIFF_SUB_DIM), diff_q_norm)
    dk = rms_norm(dk.reshape(b, s, 2 * DIFF_HEADS, DIFF_SUB_DIM), diff_k_norm)
    dq = apply_partial_rope(dq, cos, sin).reshape(b, s, DIFF_HEADS, 2, DIFF_SUB_DIM)
    dk = apply_partial_rope(dk, cos, sin).reshape(b, s, DIFF_HEADS, 2, DIFF_SUB_DIM)
    dv = dv.reshape(b, s, DIFF_HEADS, DIFF_V_DIM)
    lp = diff_lambda.astype(jnp.float32)
    lam = (jnp.exp(jnp.sum(lp[0] * lp[1])) - jnp.exp(jnp.sum(lp[2] * lp[3]))
           + lambda_init)
    y_a = diff_attention(dq, dk, dv, lam, lambda_init, diff_subln)

    nq = rms_norm(nq.reshape(b, s, NSA_HEADS, NSA_HEAD_DIM), nsa_q_norm)
    q_rot = apply_partial_rope(nq, cos, sin)
    grp = (b, s, NSA_KV_GROUPS, NSA_GROUP_SIZE, NSA_HEAD_DIM)
    kv_shape = (b, s, NSA_KV_GROUPS, NSA_HEAD_DIM)
    kc = rms_norm(compress_tokens(kc_r.reshape(kv_shape), cmp_pos[0], cmp_w1[0], cmp_w2[0]),
                  nsa_k_norm)
    vc = compress_tokens(vc_r.reshape(kv_shape), cmp_pos[1], cmp_w1[1], cmp_w2[1])
    ks = apply_partial_rope(rms_norm(ks_r.reshape(kv_shape), nsa_k_norm), cos, sin)
    kw = apply_partial_rope(rms_norm(kw_r.reshape(kv_shape), nsa_k_norm), cos, sin)
    gates = jax.nn.sigmoid(ng.reshape(b, s, NSA_KV_GROUPS, NSA_GROUP_SIZE, 3))
    y_b = nsa_attention(q_rot.reshape(grp), nq.reshape(grp), kc, vc, ks,
                        vs_r.reshape(kv_shape), kw, vw_r.reshape(kv_shape), gates)

    merged = (jax.nn.sigmoid(g_a) * (y_a @ w_proj_diff) +
              jax.nn.sigmoid(g_b) * (y_b @ w_proj_nsa))
    x = x + merged @ w_out

    h2 = rms_norm(x, norm_mlp)
    x = x + jnp.square(jax.nn.relu(h2 @ w_mlp_up)) @ w_mlp_down

    e = rms_norm(p_i @ w_ple_proj, norm_ple)
    x = x + jax.nn.sigmoid(rms_norm(x) @ w_ple_gate) * e
    return x


def setup_inputs(seed: int = 0) -> dict:
    key = jax.random.key(seed)
    ks = jax.random.split(key, 24)

    def nrm(k, shape, scale):
        return jax.random.normal(k, shape, dtype=jnp.float32) * scale

    def gain(k, n):
        return 1.0 + 0.1 * jax.random.normal(k, (DEPTH, n), dtype=jnp.float32)

    return {
        'x': nrm(ks[0], (BATCH, SEQ, D_MODEL), 1.0),
        'p': nrm(ks[1], (DEPTH, BATCH, SEQ, PLE_DIM), 1.0),
        'positions': jnp.broadcast_to(jnp.arange(SEQ, dtype=jnp.int32), (BATCH, SEQ)),
        'norm_mix': gain(ks[2], D_MODEL),
        'w_in': nrm(ks[3], (DEPTH, D_MODEL, IN_W), D_MODEL ** -0.5),
        'diff_q_norm': gain(ks[4], DIFF_SUB_DIM),
        'diff_k_norm': gain(ks[5], DIFF_SUB_DIM),
        'diff_lambda': nrm(ks[6], (DEPTH, 4, DIFF_SUB_DIM), 0.1),
        'diff_subln': gain(ks[7], DIFF_V_DIM),
        'nsa_q_norm': gain(ks[8], NSA_HEAD_DIM),
        'nsa_k_norm': gain(ks[9], NSA_HEAD_DIM),
        'cmp_pos': nrm(ks[10], (DEPTH, 2, CMP_BLOCK, NSA_HEAD_DIM), 0.1),
        'cmp_w1': nrm(ks[11], (DEPTH, 2, CMP_BLOCK * NSA_HEAD_DIM, CMP_HIDDEN),
                      (CMP_BLOCK * NSA_HEAD_DIM) ** -0.5),
        'cmp_w2': nrm(ks[12], (DEPTH, 2, CMP_HIDDEN, NSA_HEAD_DIM), CMP_HIDDEN ** -0.5),
        'w_proj_diff': nrm(ks[13], (DEPTH, DIFF_W, D_MODEL), DIFF_W ** -0.5),
        'w_proj_nsa': nrm(ks[14], (DEPTH, NSA_W, D_MODEL), NSA_W ** -0.5),
        'w_out': nrm(ks[15], (DEPTH, D_MODEL, D_MODEL), D_MODEL ** -0.5),
        'norm_mlp': gain(ks[16], D_MODEL),
        'w_mlp_up': nrm(ks[17], (DEPTH, D_MODEL, D_FF), D_MODEL ** -0.5),
        'w_mlp_down': nrm(ks[18], (DEPTH, D_FF, D_MODEL), D_FF ** -0.5),
        'w_ple_proj': nrm(ks[19], (DEPTH, PLE_DIM, D_MODEL), PLE_DIM ** -0.5),
        'norm_ple': gain(ks[20], D_MODEL),
        'w_ple_gate': nrm(ks[21], (DEPTH, D_MODEL, D_MODEL), D_MODEL ** -0.5),
    }


def reference(x, p, positions, norm_mix, w_in, diff_q_norm, diff_k_norm, diff_lambda,
              diff_subln, nsa_q_norm, nsa_k_norm, cmp_pos, cmp_w1, cmp_w2, w_proj_diff,
              w_proj_nsa, w_out, norm_mlp, w_mlp_up, w_mlp_down, w_ple_proj, norm_ple,
              w_ple_gate):
    cos, sin = rope_tables(positions, NSA_HEAD_DIM // ROPE_FRACTION)
    for i in range(DEPTH):
        lambda_init = 0.8 - 0.6 * math.exp(-0.3 * i)
        x = hybrid_layer(x, p[i], cos, sin, lambda_init, norm_mix[i], w_in[i],
                         diff_q_norm[i], diff_k_norm[i], diff_lambda[i], diff_subln[i],
                         nsa_q_norm[i], nsa_k_norm[i], cmp_pos[i], cmp_w1[i], cmp_w2[i],
                         w_proj_diff[i], w_proj_nsa[i], w_out[i], norm_mlp[i],
                         w_mlp_up[i], w_mlp_down[i], w_ple_proj[i], norm_ple[i],
                         w_ple_gate[i])
    return x
```

```cpp
#include <hip/hip_runtime.h>
#include <hip/hip_cooperative_groups.h>
#include <cstdio>
#include <cstdint>
namespace cg = cooperative_groups;

#define DI __device__ __forceinline__
#define LAS __attribute__((address_space(3)))
typedef unsigned short bf16_t;
typedef short bf16x8 __attribute__((ext_vector_type(8)));
typedef short s16x4 __attribute__((ext_vector_type(4)));
typedef float f32x2 __attribute__((ext_vector_type(2)));
typedef float f32x4 __attribute__((ext_vector_type(4)));
typedef float f32x16 __attribute__((ext_vector_type(16)));
typedef unsigned u32x2 __attribute__((ext_vector_type(2)));
typedef unsigned u32x4 __attribute__((ext_vector_type(4)));
typedef __bf16 bf16x2_t __attribute__((ext_vector_type(2)));

constexpr int BATCH = 4, SEQ = 4096, DM = 2048, T = BATCH * SEQ;
constexpr int INW = 9008, LDZ = 9216, DFF = 8192, PLE = 256;
constexpr int ZC_DQ = 0, ZC_DK = 1024, ZC_DV = 2048, ZC_NQ = 3072, ZC_KC = 4096, ZC_VC = 4224, ZC_KS = 4352, ZC_VS = 4480,
              ZC_KW = 4608, ZC_VW = 4736, ZC_NG = 4864, ZC_GA = 4912, ZC_GB = 6960;
constexpr float NORM_EPS = 1e-6f;
constexpr float SC_L2E = 0.125f * 1.4426950408889634f;
constexpr int NWAVES = 8, NTHREADS = 512;

constexpr size_t MiB = 1u << 20;
constexpr size_t WS_WIN = 0, WS_WPD = 36 * MiB, WS_WPN = 40 * MiB, WS_WOUT = 44 * MiB, WS_WC1 = 52 * MiB, WS_WUP = 54 * MiB, WS_WDN = 86 * MiB,
                 WS_WGATE = 118 * MiB, WS_WPLE = 126 * MiB, WS_H = 127 * MiB, WS_Z = 191 * MiB, WS_CTL = 511 * MiB, WS_END = 511 * MiB + 65536;
constexpr size_t WS_PB = 0, WS_SSQ = 8 * MiB, WS_PE = 16 * MiB, WS_X1B = WS_Z, WS_HID = WS_Z + 64 * MiB;
constexpr size_t DO_YA = 0, DO_YB = 32 * MiB, DO_BLK = 64 * MiB, DO_HID = 80 * MiB, DO_KC = 82 * MiB, DO_VC = 83 * MiB, DO_QP = 84 * MiB,
                 DO_ROPE = 92 * MiB, DO_KD = 93 * MiB;
constexpr int LDS_BYTES = 147456, RING_BYTES = 131072, LDSCTL_OFF = RING_BYTES, MISC_OFF = LDSCTL_OFF + 320;
constexpr size_t CTL_ZERO_BYTES = 16384;

DI unsigned pk2(float lo, float hi) { f32x2 v = {lo, hi}; bf16x2_t b = __builtin_convertvector(v, bf16x2_t); return __builtin_bit_cast(unsigned, b); }
DI float bf2f(unsigned short u) { return __uint_as_float(((unsigned)u) << 16); }
DI float bflo(unsigned u) { return __uint_as_float(u << 16); }
DI float bfhi(unsigned u) { return __uint_as_float(u & 0xffff0000u); }
DI float sigmoidf_(float x) { return __builtin_amdgcn_rcpf(1.0f + __builtin_amdgcn_exp2f(x * -1.4426950408889634f)); }
DI float wave_sum(float v) {
#pragma unroll
    for (int o = 1; o < 64; o <<= 1) v += __shfl_xor(v, o);
    return v;
}
#define LDS_WAIT() asm volatile("s_waitcnt lgkmcnt(0)" ::: "memory")
#define MFMA32(a, b, c) __builtin_amdgcn_mfma_f32_32x32x16_bf16((a), (b), (c), 0, 0, 0)
DI int crow(int r, int hi) { return (r & 3) + 8 * (r >> 2) + 4 * hi; }

namespace pg8 {
constexpr int BM = 256, BK = 64, HALF = 128, HTB = HALF * BK * 2, NXCD = 8, WGM = 3;
DI int lds_byte(int r, int c) { const int st = (r >> 4) * 2 + (c >> 5), rr = r & 15, cc = c & 31, ob = rr * 64 + cc * 2; return st * 1024 + (ob ^ (((ob >> 9) & 1) << 5)); }
DI void stage_rc(int b, int& R, int& C) { const int st = b / 1024, sb = b % 1024, swz = sb ^ (((sb >> 9) & 1) << 5); R = (st >> 1) * 16 + swz / 64; C = (st & 1) * 32 + (swz % 64) / 2; }
DI int perm32(int rho) { const int n = rho >> 4, i = rho & 15; return 8 * (i >> 2) + 4 * n + (i & 3); }

struct Unit { int pm, pn; };
struct Gemm { const bf16_t* A; const bf16_t* Bt; int M, N, K; };

struct StaticOrder {
    int nM, nN, nwg, G, c;
    DI void init(int M, int N, int G_, int c_) { nM = M / BM; nN = N / BM; nwg = nM * nN; G = G_; c = c_; }
    DI bool next(int i, Unit& u) const {
        const long L = (long)i * G + c; if (L >= nwg) return false;
        int wgid = (int)L; { const int q = nwg / NXCD, r = nwg % NXCD, xcd = wgid % NXCD, off = wgid / NXCD; wgid = (xcd < r ? xcd * (q + 1) : r * (q + 1) + (xcd - r) * q) + off; }
#ifndef PG8_NMAJOR
#define PG8_NMAJOR 1
#endif
        if (!PG8_NMAJOR) {
            const int nig = WGM * nN, gid = wgid / nig, fm = gid * WGM, gsz = (nM - fm) < WGM ? (nM - fm) : WGM;
            u.pm = fm + ((wgid % nig) % gsz); u.pn = (wgid % nig) / gsz;
        } else {
            const int nig = WGM * nM, gid = wgid / nig, fn = gid * WGM, gsz = (nN - fn) < WGM ? (nN - fn) : WGM;
            u.pn = fn + ((wgid % nig) % gsz); u.pm = (wgid % nig) / gsz;
        }
        return true;
    }
};
struct CmpOrder {
    int c;
    DI bool next(int i, Unit& u) const { if (i > 0 || c >= 16) return false; u.pm = c; u.pn = c >> 3; return true; }
};

template <class Epi, class Sched, bool ALIGN_EPI, bool SP2>
DI void gemm_phase(LAS unsigned char* lds, const Gemm g, const Sched& S, const Epi& E) {
    const int tid = threadIdx.x, wid = __builtin_amdgcn_readfirstlane(tid >> 6), lane = tid & 63, wr = wid >> 2, wc = wid & 3, fr = lane & 15, fq = lane >> 4;
    const int K = g.K, nt = K / BK;
    unsigned voffA[2], voffB[2];
#pragma unroll
    for (int i = 0; i < 2; ++i) { int R, C; stage_rc(tid * 16 + i * 8192, R, C); const int Rb = Epi::PERM ? ((R & ~31) + perm32(R & 31)) : R;
        voffA[i] = (unsigned)(R * K + C) * 2u; voffB[i] = (unsigned)(Rb * K + C) * 2u; }
    const size_t kstep = (size_t)(BK * 2);
    const size_t hstep = (size_t)HALF * K * 2;
    const size_t tstep = 2 * hstep;
    const unsigned ldsw = (unsigned)wid * 1024u;
    const int aoff = lds_byte(wr * 64 + fr, fq * 8), boff = lds_byte(wc * 32 + fr, fq * 8);
#define PG8_SA(b, h) (((b) * 2 + (h)) * HTB)
#define PG8_SB(b, h) ((4 + (b) * 2 + (h)) * HTB)
#define PG8_STAGE(bufoff, gbase, voff) do { _Pragma("unroll") for (int _i = 0; _i < 2; ++_i) \
        __builtin_amdgcn_global_load_lds((const unsigned*)((const char*)(gbase) + (voff)[_i]), (LAS unsigned*)(lds + (bufoff) + ldsw + _i * 8192), 16, 0, 0); } while (0)
#define PG8_LDA(dst, b, h) do { _Pragma("unroll") for (int m = 0; m < 4; ++m) _Pragma("unroll") for (int k = 0; k < 2; ++k) dst[m][k] = *(const LAS bf16x8*)(lds + PG8_SA(b, h) + aoff + m * 2048 + k * 1024); } while (0)
#define PG8_LDB(dst, b, h) do { _Pragma("unroll") for (int n = 0; n < 2; ++n) _Pragma("unroll") for (int k = 0; k < 2; ++k) dst[n][k] = *(const LAS bf16x8*)(lds + PG8_SB(b, h) + boff + n * 2048 + k * 1024); } while (0)
#define PG8_MMA(ai, bj, At, Bt) do { __builtin_amdgcn_s_setprio(1); _Pragma("unroll") for (int m = 0; m < 4; ++m) _Pragma("unroll") for (int n = 0; n < 2; ++n) _Pragma("unroll") for (int k = 0; k < 2; ++k) \
        acc[ai][bj][m][n] = __builtin_amdgcn_mfma_f32_16x16x32_bf16(Bt[n][k], At[m][k], acc[ai][bj][m][n], 0, 0, 0); __builtin_amdgcn_s_setprio(0); } while (0)
#define PG8_WAIT_V(n) asm volatile("s_waitcnt vmcnt(" #n ")" ::: "memory")
#define PG8_WAIT_L(n) asm volatile("s_waitcnt lgkmcnt(" #n ")" ::: "memory")
#define PG8_BAR __builtin_amdgcn_s_barrier()
#define PG8_SCHED __builtin_amdgcn_sched_barrier(0)
    Unit cur, nxt; int ui = 0;
    if (!S.next(0, cur)) return;
    f32x4 acc[2][2][4][2];
#pragma unroll
    for (int a = 0; a < 2; ++a)
#pragma unroll
        for (int b = 0; b < 2; ++b)
#pragma unroll
            for (int m = 0; m < 4; ++m)
#pragma unroll
                for (int n = 0; n < 2; ++n) acc[a][b][m][n] = (f32x4){0.f, 0.f, 0.f, 0.f};
    bf16x8 At[4][2], B0[2][2], B1[2][2];
    const char* cA = (const char*)g.A + (size_t)cur.pm * tstep; const char* cB = (const char*)g.Bt + (size_t)cur.pn * tstep;
    if constexpr (SP2) {
        PG8_STAGE(PG8_SB(0, 0), cB, voffB); PG8_STAGE(PG8_SB(0, 1), cB + hstep, voffB); PG8_STAGE(PG8_SA(0, 0), cA, voffA); PG8_STAGE(PG8_SA(0, 1), cA + hstep, voffA);
        if (wr == 1) PG8_BAR;
        PG8_WAIT_V(2); PG8_BAR;
        PG8_STAGE(PG8_SB(1, 0), cB + kstep, voffB); PG8_STAGE(PG8_SA(1, 0), cA + kstep, voffA); PG8_STAGE(PG8_SB(1, 1), cB + hstep + kstep, voffB);
        PG8_WAIT_V(6); PG8_BAR;
    } else {
        PG8_STAGE(PG8_SB(0, 0), cB, voffB); PG8_STAGE(PG8_SA(0, 0), cA, voffA); PG8_STAGE(PG8_SB(0, 1), cB + hstep, voffB); PG8_STAGE(PG8_SA(0, 1), cA + hstep, voffA);
        if (wr == 1) PG8_BAR;
        PG8_WAIT_V(4); PG8_BAR;
        PG8_STAGE(PG8_SB(1, 0), cB + kstep, voffB); PG8_STAGE(PG8_SA(1, 0), cA + kstep, voffA); PG8_STAGE(PG8_SB(1, 1), cB + hstep + kstep, voffB);
        PG8_WAIT_V(6); PG8_BAR;
    }
    for (;;) {
        const bool has_next = S.next(ui + 1, nxt);
        const char* nA = has_next ? (const char*)g.A + (size_t)nxt.pm * tstep : cA; const char* nB = has_next ? (const char*)g.Bt + (size_t)nxt.pn * tstep : cB;
        for (int t = 0; t < nt; t += 2) {
            const bool last = (t == nt - 2);
            const char* a1 = cA + (size_t)(t + 1) * kstep;
            const char* a2 = last ? nA : cA + (size_t)(t + 2) * kstep; const char* b2 = last ? nB : cB + (size_t)(t + 2) * kstep;
            const char* a3 = a2 + kstep; const char* b3 = b2 + kstep;
            if constexpr (SP2) {
            PG8_LDB(B0, 0, 0); PG8_LDB(B1, 0, 1); PG8_SCHED; PG8_LDA(At, 0, 0); PG8_STAGE(PG8_SA(1, 1), a1 + hstep, voffA);
            PG8_WAIT_V(8); PG8_WAIT_L(0); PG8_BAR; PG8_MMA(0, 0, At, B0); PG8_MMA(0, 1, At, B1); PG8_BAR; PG8_SCHED;
            PG8_LDA(At, 0, 1); PG8_STAGE(PG8_SB(0, 0), b2, voffB); PG8_STAGE(PG8_SB(0, 1), b2 + hstep, voffB); PG8_STAGE(PG8_SA(0, 0), a2, voffA);
            PG8_WAIT_V(8); PG8_WAIT_L(0); PG8_BAR; PG8_MMA(1, 0, At, B0); PG8_MMA(1, 1, At, B1); PG8_BAR; PG8_SCHED;
            PG8_LDB(B0, 1, 0); PG8_LDB(B1, 1, 1); PG8_SCHED; PG8_LDA(At, 1, 0); PG8_STAGE(PG8_SA(0, 1), a2 + hstep, voffA);
            PG8_WAIT_V(8); PG8_WAIT_L(0); PG8_BAR; PG8_MMA(0, 0, At, B0); PG8_MMA(0, 1, At, B1); PG8_BAR; PG8_SCHED;
            PG8_LDA(At, 1, 1); PG8_STAGE(PG8_SB(1, 0), b3, voffB); PG8_STAGE(PG8_SB(1, 1), b3 + hstep, voffB); PG8_STAGE(PG8_SA(1, 0), a3, voffA);
            PG8_WAIT_V(8); PG8_WAIT_L(0); PG8_BAR; PG8_MMA(1, 0, At, B0); PG8_MMA(1, 1, At, B1); PG8_BAR; PG8_SCHED;
            } else {
            PG8_LDB(B0, 0, 0); PG8_SCHED; PG8_LDA(At, 0, 0); PG8_STAGE(PG8_SA(1, 1), a1 + hstep, voffA);
            PG8_WAIT_L(8); PG8_BAR; PG8_WAIT_L(0); PG8_MMA(0, 0, At, B0); PG8_BAR; PG8_SCHED;
            PG8_LDB(B1, 0, 1); PG8_STAGE(PG8_SB(0, 0), b2, voffB);
            PG8_BAR; PG8_WAIT_L(0); PG8_MMA(0, 1, At, B1); PG8_BAR;
            PG8_LDA(At, 0, 1); PG8_STAGE(PG8_SA(0, 0), a2, voffA);
            PG8_BAR; PG8_WAIT_L(0); PG8_MMA(1, 0, At, B0); PG8_BAR; PG8_SCHED;
            PG8_STAGE(PG8_SB(0, 1), b2 + hstep, voffB);
            PG8_WAIT_V(6); PG8_BAR; PG8_MMA(1, 1, At, B1); PG8_BAR;
            PG8_LDB(B0, 1, 0); PG8_SCHED; PG8_LDA(At, 1, 0); PG8_STAGE(PG8_SA(0, 1), a2 + hstep, voffA);
            PG8_WAIT_L(8); PG8_BAR; PG8_WAIT_L(0); PG8_MMA(0, 0, At, B0); PG8_BAR; PG8_SCHED;
            PG8_LDB(B1, 1, 1); PG8_STAGE(PG8_SB(1, 0), b3, voffB);
            PG8_BAR; PG8_WAIT_L(0); PG8_MMA(0, 1, At, B1); PG8_BAR;
            PG8_LDA(At, 1, 1); PG8_STAGE(PG8_SA(1, 0), a3, voffA);
            PG8_BAR; PG8_WAIT_L(0); PG8_MMA(1, 0, At, B0); PG8_BAR; PG8_SCHED;
            PG8_STAGE(PG8_SB(1, 1), b3 + hstep, voffB);
            PG8_WAIT_V(6); PG8_BAR; PG8_MMA(1, 1, At, B1); PG8_BAR;
            }
        }
        if constexpr (ALIGN_EPI) { if (wr == 0) PG8_BAR; }
        E(acc, cur, wr, wc, fr, fq);
        if (!has_next) break;
#pragma unroll
        for (int a = 0; a < 2; ++a)
#pragma unroll
            for (int b = 0; b < 2; ++b)
#pragma unroll
                for (int m = 0; m < 4; ++m)
#pragma unroll
                    for (int n = 0; n < 2; ++n) acc[a][b][m][n] = (f32x4){0.f, 0.f, 0.f, 0.f};
        cur = nxt; cA = nA; cB = nB; ++ui;
        if constexpr (ALIGN_EPI) { if (wr == 1) PG8_BAR; }
    }
    PG8_WAIT_V(0);
    if constexpr (!ALIGN_EPI) { if (wr == 0) PG8_BAR; }
    PG8_BAR;
#undef PG8_SA
#undef PG8_SB
#undef PG8_STAGE
#undef PG8_LDA
#undef PG8_LDB
#undef PG8_MMA
#undef PG8_WAIT_V
#undef PG8_WAIT_L
#undef PG8_BAR
#undef PG8_SCHED
}

DI float act_relu2(float v) { const float r = v > 0.f ? v : 0.f; return r * r; }
DI float act_gelu_tanh(float v) { const float u = 0.7978845608028654f * (v + 0.044715f * v * v * v); return v * __builtin_amdgcn_rcpf(1.0f + __builtin_amdgcn_exp2f(u * -2.8853900817779268f)); }

template <int ACT, bool CMP, bool HAS_IN = false, bool HAS_OUT = false> struct EpiBf16 {
    static constexpr bool PERM = true;
    bf16_t* O; int ldc; const float* ssq_in; float* ssq_out;
    DI void operator()(const f32x4 (&acc)[2][2][4][2], const Unit& u, int wr, int wc, int fr, int fq) const {
        const int row0 = u.pm * BM + wr * 64 + fr; const int col0 = (CMP ? 0 : u.pn * BM) + wc * 32 + 8 * fq;
        float rs8[2][4];
        if (HAS_IN) {
#pragma unroll
            for (int ai = 0; ai < 2; ++ai)
#pragma unroll
                for (int m = 0; m < 4; ++m) rs8[ai][m] = ssq_in[row0 + ai * HALF + m * 16];
#pragma unroll
            for (int ai = 0; ai < 2; ++ai)
#pragma unroll
                for (int m = 0; m < 4; ++m) rs8[ai][m] = rsqrtf(rs8[ai][m] * (1.f / DM) + NORM_EPS);
            __builtin_amdgcn_sched_barrier(0);
        }
#pragma unroll
        for (int ai = 0; ai < 2; ++ai)
#pragma unroll
            for (int m = 0; m < 4; ++m) { const int r = row0 + ai * HALF + m * 16; bf16_t* rowp = O + (size_t)r * ldc + col0;
                float rsc = 1.f; if (HAS_IN) rsc = rs8[ai][m];
                float sq = 0.f;
#pragma unroll
                for (int bj = 0; bj < 2; ++bj) { f32x4 v0 = acc[ai][bj][m][0], v1 = acc[ai][bj][m][1];
                    if (HAS_IN) { v0 = v0 * rsc; v1 = v1 * rsc; }
                    if (ACT == 1) { for (int j = 0; j < 4; ++j) { v0[j] = act_relu2(v0[j]); v1[j] = act_relu2(v1[j]); } }
                    if (ACT == 2) { for (int j = 0; j < 4; ++j) { v0[j] = act_gelu_tanh(v0[j]); v1[j] = act_gelu_tanh(v1[j]); } }
                    if (HAS_OUT) sq += (v0[0] * v0[0] + v0[1] * v0[1]) + (v0[2] * v0[2] + v0[3] * v0[3]) + (v1[0] * v1[0] + v1[1] * v1[1]) + (v1[2] * v1[2] + v1[3] * v1[3]);
                    u32x4 w; w.x = pk2(v0[0], v0[1]); w.y = pk2(v0[2], v0[3]); w.z = pk2(v1[0], v1[1]); w.w = pk2(v1[2], v1[3]);
                    *(u32x4*)(rowp + bj * HALF) = w; }
                if (HAS_OUT) { sq += __shfl_xor(sq, 16); sq += __shfl_xor(sq, 32); if (fq == 0) atomicAdd(ssq_out + r, sq); } }
    }
};
template <bool ADD> struct EpiGate {
    static constexpr bool PERM = true;
    bf16_t* O; int ldc; const bf16_t* Gt; int ldg;
    DI void operator()(const f32x4 (&acc)[2][2][4][2], const Unit& u, int wr, int wc, int fr, int fq) const {
        const int row0 = u.pm * BM + wr * 64 + fr; const int col0 = u.pn * BM + wc * 32 + 8 * fq;
#pragma unroll
        for (int ai = 0; ai < 2; ++ai) {
            u32x4 gw[4][2], pw[4][2];
#pragma unroll
            for (int m = 0; m < 4; ++m)
#pragma unroll
                for (int bj = 0; bj < 2; ++bj) { const size_t r = (size_t)(row0 + ai * HALF + m * 16);
                    gw[m][bj] = *(const u32x4*)(Gt + r * ldg + col0 + bj * HALF);
                    if (ADD) pw[m][bj] = *(const u32x4*)(O + r * ldc + col0 + bj * HALF); }
            __builtin_amdgcn_sched_barrier(0);
#pragma unroll
            for (int m = 0; m < 4; ++m) { const size_t r = (size_t)(row0 + ai * HALF + m * 16);
#pragma unroll
                for (int bj = 0; bj < 2; ++bj) { const f32x4 v0 = acc[ai][bj][m][0], v1 = acc[ai][bj][m][1]; const u32x4 g = gw[m][bj];
                    float o[8];
                    o[0] = sigmoidf_(bflo(g.x)) * v0[0]; o[1] = sigmoidf_(bfhi(g.x)) * v0[1]; o[2] = sigmoidf_(bflo(g.y)) * v0[2]; o[3] = sigmoidf_(bfhi(g.y)) * v0[3];
                    o[4] = sigmoidf_(bflo(g.z)) * v1[0]; o[5] = sigmoidf_(bfhi(g.z)) * v1[1]; o[6] = sigmoidf_(bflo(g.w)) * v1[2]; o[7] = sigmoidf_(bfhi(g.w)) * v1[3];
                    if (ADD) { const u32x4 p = pw[m][bj];
                        o[0] += bflo(p.x); o[1] += bfhi(p.x); o[2] += bflo(p.y); o[3] += bfhi(p.y); o[4] += bflo(p.z); o[5] += bfhi(p.z); o[6] += bflo(p.w); o[7] += bfhi(p.w); }
                    u32x4 w; w.x = pk2(o[0], o[1]); w.y = pk2(o[2], o[3]); w.z = pk2(o[4], o[5]); w.w = pk2(o[6], o[7]);
                    *(u32x4*)(O + r * ldc + col0 + bj * HALF) = w; } }
        }
    }
};
struct EpiRes {
    static constexpr bool PERM = false;
    const float* base; float* out; int ldc; bf16_t* xb; float* ssq;
    DI void operator()(const f32x4 (&acc)[2][2][4][2], const Unit& u, int wr, int wc, int fr, int fq) const {
        const int row0 = u.pm * BM + wr * 64 + fr; const int col0 = u.pn * BM + wc * 32 + 4 * fq;
        f32x4 bs[2][2][2][2];
#define ER_LOAD(q, S) do { _Pragma("unroll") for (int mm = 0; mm < 2; ++mm) _Pragma("unroll") for (int bj = 0; bj < 2; ++bj) _Pragma("unroll") for (int n = 0; n < 2; ++n) \
            bs[S][mm][bj][n] = *(const f32x4*)(base + (size_t)(row0 + ((q) >> 1) * HALF + (2 * ((q) & 1) + mm) * 16) * ldc + col0 + bj * HALF + n * 16); } while (0)
        ER_LOAD(0, 0);
#pragma unroll
        for (int q = 0; q < 4; ++q) {
            if (q + 1 < 4) { if (q & 1) ER_LOAD(q + 1, 0); else ER_LOAD(q + 1, 1); }
            __builtin_amdgcn_sched_barrier(0);
            const int ai = q >> 1, mh = q & 1;
#pragma unroll
            for (int mm = 0; mm < 2; ++mm) { const int m = 2 * mh + mm; const int r = row0 + ai * HALF + m * 16; const size_t off = (size_t)r * ldc + col0; float sq = 0.f;
#pragma unroll
                for (int bj = 0; bj < 2; ++bj)
#pragma unroll
                    for (int n = 0; n < 2; ++n) { const int cc = bj * HALF + n * 16; const f32x4 o = bs[q & 1][mm][bj][n] + acc[ai][bj][m][n];
                        *(f32x4*)(out + off + cc) = o; sq += (o[0] * o[0] + o[1] * o[1]) + (o[2] * o[2] + o[3] * o[3]);
                        u32x2 w; w.x = pk2(o[0], o[1]); w.y = pk2(o[2], o[3]); *(u32x2*)(xb + off + cc) = w; }
                sq += __shfl_xor(sq, 16); sq += __shfl_xor(sq, 32); if (fq == 0) atomicAdd(ssq + r, sq); }
            __builtin_amdgcn_sched_barrier(0);
        }
#undef ER_LOAD
    }
};
struct EpiFinal {
    static constexpr bool PERM = false;
    const float* base; float* out; int ldc; const bf16_t* pe; const float* ssq2; const float* ssqpe; const float* gn;
    DI void operator()(const f32x4 (&acc)[2][2][4][2], const Unit& u, int wr, int wc, int fr, int fq) const {
        const int row0 = u.pm * BM + wr * 64 + fr; const int col0 = u.pn * BM + wc * 32 + 4 * fq;
        float s2a[2][4], spa[2][4];
#pragma unroll
        for (int ai = 0; ai < 2; ++ai)
#pragma unroll
            for (int m = 0; m < 4; ++m) { const int r = row0 + ai * HALF + m * 16; s2a[ai][m] = ssq2[r]; spa[ai][m] = ssqpe[r]; }
#pragma unroll
        for (int ai = 0; ai < 2; ++ai)
#pragma unroll
        for (int mh = 0; mh < 2; ++mh) {
            f32x4 bs[2][2][2]; u32x2 pw[2][2][2]; float s2[2], sp[2];
#pragma unroll
            for (int mm = 0; mm < 2; ++mm) { const int r = row0 + ai * HALF + (2 * mh + mm) * 16; s2[mm] = s2a[ai][2 * mh + mm]; sp[mm] = spa[ai][2 * mh + mm];
#pragma unroll
                for (int bj = 0; bj < 2; ++bj)
#pragma unroll
                    for (int n = 0; n < 2; ++n) { const size_t o_ = (size_t)r * ldc + col0 + bj * HALF + n * 16; bs[mm][bj][n] = *(const f32x4*)(base + o_); pw[mm][bj][n] = *(const u32x2*)(pe + o_); } }
            __builtin_amdgcn_sched_barrier(0);
#pragma unroll
            for (int mm = 0; mm < 2; ++mm) { const int m = 2 * mh + mm; const int r = row0 + ai * HALF + m * 16; const size_t off = (size_t)r * ldc + col0;
                const float rs2 = rsqrtf(s2[mm] * (1.f / DM) + NORM_EPS), rsr = rsqrtf(sp[mm] * (1.f / DM) + NORM_EPS);
#pragma unroll
                for (int bj = 0; bj < 2; ++bj)
#pragma unroll
                    for (int n = 0; n < 2; ++n) { const int cc = bj * HALF + n * 16; const f32x4 b4 = bs[mm][bj][n], gg = *(const f32x4*)(gn + col0 + cc); const u32x2 p = pw[mm][bj][n]; const f32x4 a = acc[ai][bj][m][n] * rs2; f32x4 o;
                        o[0] = b4[0] + sigmoidf_(a[0]) * (bflo(p.x) * rsr * gg[0]); o[1] = b4[1] + sigmoidf_(a[1]) * (bfhi(p.x) * rsr * gg[1]);
                        o[2] = b4[2] + sigmoidf_(a[2]) * (bflo(p.y) * rsr * gg[2]); o[3] = b4[3] + sigmoidf_(a[3]) * (bfhi(p.y) * rsr * gg[3]);
                        *(f32x4*)(out + off + cc) = o; } }
        }
    }
};
}

struct Params { const float* in[23]; float* out; unsigned char* ws; };

struct Frame {
    LAS unsigned char* lds;
    int tid, lane, wave, G, bid, vcu;
    const float *x, *p; const int* pos;
    const float *norm_mix, *w_in, *dqn, *dkn, *dlam, *subln, *nqn, *nkn, *cpos, *cw1, *cw2, *wpd, *wpn, *wout, *norm_mlp, *wup, *wdn, *wple, *norm_ple, *wgate;
    float* out;
    bf16_t *WIN, *WUP, *WDN, *WOUT, *WGATE, *WPD, *WPN, *WPLE, *WC1, *H, *Z, *PE, *PB, *X1B, *HIDN;
    float *SSQ1, *SSQ2, *SSQPE;
    bf16_t *YA, *YB, *BLK, *HID, *KC, *VC, *QP, *KD, *VD, *NKV;
    float* ROPE;
};

DI void transpose_item(const float* W, int K, int N, int Npad, bf16_t* WT, LAS float* scr, int item, int lane, const float* kscale = nullptr) {
    const int nblk = Npad / 32, kb = item / nblk, nb = item % nblk, k0 = 64 * kb, n0 = 32 * nb;
    const int nn = n0 + (lane & 31);
    float tv[32];
#pragma unroll
    for (int i = 0; i < 32; ++i) { const int kk = 2 * i + (lane >> 5); tv[i] = (nn < N) ? W[(size_t)(k0 + kk) * N + nn] : 0.f; }
    if (kscale) {
#pragma unroll
        for (int i = 0; i < 32; ++i) tv[i] *= kscale[k0 + 2 * i + (lane >> 5)];
    }
#pragma unroll
    for (int i = 0; i < 32; ++i) { const int kk = 2 * i + (lane >> 5); scr[kk * 33 + (lane & 31)] = tv[i]; }
    LDS_WAIT(); asm volatile("" ::: "memory");
    const int c = lane & 7;
#pragma unroll
    for (int j = 0; j < 4; ++j) { const int n = (lane >> 3) + 8 * j; const LAS float* s = scr + (8 * c) * 33 + n;
        u32x4 o; o.x = pk2(s[0 * 33], s[1 * 33]); o.y = pk2(s[2 * 33], s[3 * 33]); o.z = pk2(s[4 * 33], s[5 * 33]); o.w = pk2(s[6 * 33], s[7 * 33]);
        *(u32x4*)(WT + (size_t)(n0 + n) * K + k0 + 8 * c) = o; }
    LDS_WAIT(); asm volatile("" ::: "memory");
}
DI void rms_row_bf16(const float* xrow, const float* gain, bf16_t* orow, int lane) {
    const f32x4* xr = (const f32x4*)xrow + lane;
    f32x4 v[8]; float s = 0.f;
#pragma unroll
    for (int j = 0; j < 8; ++j) { v[j] = xr[64 * j]; s += (v[j].x * v[j].x + v[j].y * v[j].y) + (v[j].z * v[j].z + v[j].w * v[j].w); }
    const float rs = rsqrtf(wave_sum(s) * (1.f / DM) + NORM_EPS);
    u32x2* o8 = (u32x2*)orow + lane;
#pragma unroll
    for (int j = 0; j < 8; ++j) { f32x4 g = {1.f, 1.f, 1.f, 1.f}; if (gain) g = *((const f32x4*)gain + lane + 64 * j);
        u32x2 w; w.x = pk2(v[j].x * rs * g.x, v[j].y * rs * g.y); w.y = pk2(v[j].z * rs * g.z, v[j].w * rs * g.w); o8[64 * j] = w; }
}
DI void p0_prologue(Frame& F) {
    LAS float* scr = (LAS float*)(F.lds + F.wave * 16384);
    const int gw = F.vcu * NWAVES + F.wave, NGW = F.G * NWAVES;
    constexpr int I_IN = 32 * 288, I_UP = 32 * 256, I_DN = 128 * 64, I_SQ = 32 * 64, I_PJ = 16 * 64, I_PLE = 4 * 64, I_C1 = 32 * 8;
    constexpr int NITEMS = I_IN + I_UP + I_DN + 2 * I_SQ + 2 * I_PJ + I_PLE + 2 * I_C1;
    for (int it = gw; it < NITEMS; it += NGW) {
        int r = it;
        if (r < I_IN) { transpose_item(F.w_in, DM, INW, LDZ, F.WIN, scr, r, F.lane); continue; } r -= I_IN;
        if (r < I_UP) { transpose_item(F.wup, DM, DFF, DFF, F.WUP, scr, r, F.lane, F.norm_mlp); continue; } r -= I_UP;
        if (r < I_DN) { transpose_item(F.wdn, DFF, DM, DM, F.WDN, scr, r, F.lane); continue; } r -= I_DN;
        if (r < I_SQ) { transpose_item(F.wout, DM, DM, DM, F.WOUT, scr, r, F.lane); continue; } r -= I_SQ;
        if (r < I_SQ) { transpose_item(F.wgate, DM, DM, DM, F.WGATE, scr, r, F.lane); continue; } r -= I_SQ;
        if (r < I_PJ) { transpose_item(F.wpd, 1024, DM, DM, F.WPD, scr, r, F.lane); continue; } r -= I_PJ;
        if (r < I_PJ) { transpose_item(F.wpn, 1024, DM, DM, F.WPN, scr, r, F.lane); continue; } r -= I_PJ;
        if (r < I_PLE) { transpose_item(F.wple, PLE, DM, DM, F.WPLE, scr, r, F.lane); continue; } r -= I_PLE;
        if (r < I_C1) { transpose_item(F.cw1, 2048, 256, 256, F.WC1, scr, r, F.lane); continue; } r -= I_C1;
        transpose_item(F.cw1 + (size_t)2048 * 256, 2048, 256, 256, F.WC1 + (size_t)256 * 2048, scr, r, F.lane);
    }
    for (int m = gw; m < T; m += NGW) rms_row_bf16(F.x + (size_t)m * DM, F.norm_mix, F.H + (size_t)m * DM, F.lane);
    for (int e = gw * 64 + F.lane; e < T * 8; e += NGW * 64) {
        const int tok = e >> 3, j = e & 7;
        const float invf = j == 0 ? 1.0f : j == 1 ? 0.1939227432012558f : j == 2 ? 0.03760603070259094f : j == 3 ? 0.007292664609849453f :
                           j == 4 ? 0.0014142135623842478f : j == 5 ? 0.00027424818836152554f : j == 6 ? 5.318296098266728e-05f : 1.0313386155758053e-05f;
        const float ang = (float)F.pos[tok] * invf;
        double t = (double)ang * 0.15915494309189535; t -= rint(t);
        const float fr = (float)t;
        F.ROPE[tok * 16 + j] = __builtin_amdgcn_cosf(fr); F.ROPE[tok * 16 + 8 + j] = __builtin_amdgcn_sinf(fr);
    }
}

DI void head_norm_rope(const bf16_t* ptr, bf16_t* dst, const float* gain8, int sub, const float* cs, const float* sn, bf16_t* plain, bool active, float oscale = 1.0f) {
    u32x4 w = {0u, 0u, 0u, 0u};
    if (active) w = *(const u32x4*)ptr;
    float v[8] = {bflo(w.x), bfhi(w.x), bflo(w.y), bfhi(w.y), bflo(w.z), bfhi(w.z), bflo(w.w), bfhi(w.w)};
    float ss = 0.f;
#pragma unroll
    for (int j = 0; j < 8; ++j) ss += v[j] * v[j];
    ss += __shfl_xor(ss, 1); ss += __shfl_xor(ss, 2); ss += __shfl_xor(ss, 4);
    const float rs = rsqrtf(ss * (1.f / 64.f) + NORM_EPS);
    const f32x4 g0 = *(const f32x4*)gain8, g1 = *(const f32x4*)(gain8 + 4);
    float y[8];
#pragma unroll
    for (int j = 0; j < 8; ++j) y[j] = v[j] * (rs * oscale) * (j < 4 ? g0[j] : g1[j - 4]);
    if (plain && active && sub < 2) { u32x4 o; o.x = pk2(y[0], y[1]); o.y = pk2(y[2], y[3]); o.z = pk2(y[4], y[5]); o.w = pk2(y[6], y[7]); *(u32x4*)plain = o; }
    float yp[8];
#pragma unroll
    for (int j = 0; j < 8; ++j) yp[j] = __shfl_xor(y[j], 1);
    if (sub == 0) {
#pragma unroll
        for (int j = 0; j < 8; ++j) y[j] = y[j] * cs[j] - yp[j] * sn[j];
    } else if (sub == 1) {
#pragma unroll
        for (int j = 0; j < 8; ++j) y[j] = y[j] * cs[j] + yp[j] * sn[j];
    }
    if (active) { u32x4 o; o.x = pk2(y[0], y[1]); o.y = pk2(y[2], y[3]); o.z = pk2(y[4], y[5]); o.w = pk2(y[6], y[7]); *(u32x4*)dst = o; }
}
DI void p2a_blocks(Frame& F) {
    const int gw = F.vcu * NWAVES + F.wave, NGW = F.G * NWAVES, lane = F.lane, sub = lane & 7, d0 = sub * 8;
    for (int e = gw * 64 + lane; e < 3 * T; e += NGW * 64) F.SSQ1[e] = 0.f;
    for (int tok = gw; tok < T; tok += NGW) {
        bf16_t* zr = F.Z + (size_t)tok * LDZ;
        if (lane < 32) {
            const int kv = lane >> 4, g = (lane >> 3) & 1;
            const u32x4 w = *(const u32x4*)(zr + (kv ? ZC_VC : ZC_KC) + g * 64 + d0);
            const float v[8] = {bflo(w.x), bfhi(w.x), bflo(w.y), bfhi(w.y), bflo(w.z), bfhi(w.z), bflo(w.w), bfhi(w.w)};
            const int b = tok / SEQ, s = tok % SEQ;
#pragma unroll
            for (int which = 0; which < 2; ++which) {
                const int n = (s >> 4) - which;
                if (n >= 0 && n <= 254) {
                    const int l = s - 16 * n;
                    const float* pp = F.cpos + ((size_t)kv * 32 + l) * 64 + d0;
                    const f32x4 p0 = *(const f32x4*)pp, p1 = *(const f32x4*)(pp + 4);
                    u32x4 o; o.x = pk2(v[0] + p0[0], v[1] + p0[1]); o.y = pk2(v[2] + p0[2], v[3] + p0[3]); o.z = pk2(v[4] + p1[0], v[5] + p1[1]); o.w = pk2(v[6] + p1[2], v[7] + p1[3]);
                    *(u32x4*)(F.BLK + ((size_t)kv * 2048 + (size_t)(b * 2 + g) * 256 + n) * 2048 + l * 64 + d0) = o;
                }
            }
        }
    }
}
DI void p2_postprocess(Frame& F, int gw, int NGW) {
    const int lane = F.lane, sub = lane & 7, d0 = sub * 8;
    for (int tok = gw; tok < T; tok += NGW) {
        bf16_t* zr = F.Z + (size_t)tok * LDZ;
        float cs[8], sn[8];
#pragma unroll
        for (int j = 0; j < 8; ++j) { cs[j] = F.ROPE[tok * 16 + j]; sn[j] = F.ROPE[tok * 16 + 8 + j]; }
        const int b = tok / SEQ, sq = tok % SEQ;
#pragma unroll
        for (int ch = 0; ch < 2; ++ch) {
            head_norm_rope(zr + ZC_DQ + ch * 512 + lane * 8, zr + ZC_DQ + ch * 512 + lane * 8, F.dqn + d0, sub, cs, sn, nullptr, true, SC_L2E);
            head_norm_rope(zr + ZC_DK + ch * 512 + lane * 8, F.KD + ((size_t)(b * 16 + ch * 8 + (lane >> 3)) * SEQ + sq) * 64 + d0, F.dkn + d0, sub, cs, sn, nullptr, true);
            head_norm_rope(zr + ZC_NQ + ch * 512 + lane * 8, zr + ZC_NQ + ch * 512 + lane * 8, F.nqn + d0, sub, cs, sn, F.QP + ((size_t)tok * 16 + ch * 8 + (lane >> 3)) * 16 + sub * 8, true, SC_L2E);
        }
        {
          const int kind = lane < 16 ? 0 : 2, g = (lane >> 3) & 1;
          head_norm_rope(zr + (lane < 16 ? ZC_KS + lane * 8 : ZC_KW + (lane - 16) * 8), F.NKV + ((size_t)(kind * 8 + b * 2 + g) * SEQ + sq) * 64 + d0, F.nkn + d0, sub, cs, sn, nullptr, lane < 32);
          if (lane >= 32) { const int l2 = lane - 32, kind2 = l2 < 16 ? 1 : 3;
              const u32x4 w = *(const u32x4*)(zr + (l2 < 16 ? ZC_VS + l2 * 8 : ZC_VW + (l2 - 16) * 8));
              *(u32x4*)(F.NKV + ((size_t)(kind2 * 8 + b * 2 + g) * SEQ + sq) * 64 + d0) = w; } }
        {
          const int col = lane * 16, hh = col >> 7, dvi = col & 127;
          const u32x4 w0 = *(const u32x4*)(zr + ZC_DV + col), w1 = *(const u32x4*)(zr + ZC_DV + col + 8);
          bf16_t* dp = F.VD + ((size_t)(b * 8 + hh) * SEQ + sq) * 128 + dvi;
          *(u32x4*)dp = w0; *(u32x4*)(dp + 8) = w1; }
    }
}

constexpr int KP = 144;
typedef short v4i16_t __attribute__((ext_vector_type(4)));
DI s16x4 vtr(const LAS unsigned char* p) { return __builtin_bit_cast(s16x4, __builtin_amdgcn_ds_read_tr16_b64_v4i16((LAS v4i16_t*)p)); }
DI void qk_tile(f32x16& s0, f32x16& s1, const LAS unsigned char* kt, const bf16x8* qf, int r32, int hi, float soff) {
    const LAS unsigned char* kp = kt + r32 * KP + hi * 16;
    f32x16 z; for (int i = 0; i < 16; ++i) z[i] = soff;
    s0 = z; s1 = z;
#pragma unroll
    for (int c = 0; c < 4; ++c) {
        const bf16x8 a0 = *(const LAS bf16x8*)(kp + c * 32);
        const bf16x8 a1 = *(const LAS bf16x8*)(kp + 32 * KP + c * 32);
        s0 = MFMA32(a0, qf[c], s0); s1 = MFMA32(a1, qf[c], s1);
    }
}
DI bf16x8 pack8(const f32x16& p, int b) {
    u32x4 w; w.x = pk2(p[b], p[b + 1]); w.y = pk2(p[b + 2], p[b + 3]); w.z = pk2(p[b + 4], p[b + 5]); w.w = pk2(p[b + 6], p[b + 7]);
    return __builtin_bit_cast(bf16x8, w);
}
template <int NDT, int VP> DI void pv_tile(f32x16* o, const LAS unsigned char* vt, const f32x16& p0, const f32x16& p1, int lane) {
    const int hi = lane >> 5, i16 = lane & 15, q = i16 >> 2, p = i16 & 3, blk = (lane >> 4) & 1;
    const LAS unsigned char* vb = vt + (4 * hi + q) * VP + (16 * blk + 4 * p) * 2;
    bf16x8 pf[4]; pf[0] = pack8(p0, 0); pf[1] = pack8(p0, 8); pf[2] = pack8(p1, 0); pf[3] = pack8(p1, 8);
    s16x4 lo[2][4], hh[2][4];
#pragma unroll
    for (int f = 0; f < 4; ++f) { lo[0][f] = vtr(vb + (16 * f) * VP); hh[0][f] = vtr(vb + (16 * f + 8) * VP); }
#pragma unroll
    for (int dt = 0; dt < NDT; ++dt) {
        if (dt + 1 < NDT) {
#pragma unroll
            for (int f = 0; f < 4; ++f) { lo[(dt + 1) & 1][f] = vtr(vb + (16 * f) * VP + (dt + 1) * 64); hh[(dt + 1) & 1][f] = vtr(vb + (16 * f + 8) * VP + (dt + 1) * 64); }
        }
        __builtin_amdgcn_sched_barrier(0);
#pragma unroll
        for (int f = 0; f < 4; ++f) {
            const s16x4 l4 = lo[dt & 1][f], h4 = hh[dt & 1][f];
            const bf16x8 vf = {l4[0], l4[1], l4[2], l4[3], h4[0], h4[1], h4[2], h4[3]};
            o[dt] = MFMA32(vf, pf[f], o[dt]);
        }
        __builtin_amdgcn_sched_barrier(0);
    }
}
constexpr float LAZY_THR = 8.0f;
DI float xhalf_max(float v) { const unsigned u = __float_as_uint(v); auto rr = __builtin_amdgcn_permlane32_swap(u, u, false, false); return fmaxf(__uint_as_float(rr[0]), __uint_as_float(rr[1])); }
DI float xhalf_sum(float v) { const unsigned u = __float_as_uint(v); auto rr = __builtin_amdgcn_permlane32_swap(u, u, false, false); return __uint_as_float(rr[0]) + __uint_as_float(rr[1]); }
DI float tile_max(const f32x16& s0, const f32x16& s1) {
    float a = fmaxf(fmaxf(s0[0], s0[1]), s1[0]), b = fmaxf(fmaxf(s0[2], s0[3]), s1[1]); a = fmaxf(fmaxf(a, s1[2]), s1[3]);
#pragma unroll
    for (int r = 4; r < 16; r += 4) { a = fmaxf(fmaxf(a, s0[r]), s0[r + 1]); b = fmaxf(fmaxf(b, s0[r + 2]), s0[r + 3]); a = fmaxf(fmaxf(a, s1[r]), s1[r + 1]); b = fmaxf(fmaxf(b, s1[r + 2]), s1[r + 3]); }
    return fmaxf(a, b);
}
template <int NDT> DI void online_step(f32x16& s0, f32x16& s1, float& m, float& l, f32x16* o, bool lane_on) {
    (void)m; (void)o;
    const float off = lane_on ? 0.f : -INFINITY;
    float sum0 = 0.f, sum1 = 0.f;
#pragma unroll
    for (int i = 0; i < 16; ++i) { s0[i] = __builtin_amdgcn_exp2f(s0[i] + off); s1[i] = __builtin_amdgcn_exp2f(s1[i] + off); sum0 += s0[i]; sum1 += s1[i]; }
    l += sum0 + sum1;
}

template <int NDT, int VP, bool HAS_OFF> DI void softmax_pv(f32x16& s0, f32x16& s1, float& l, f32x16* o, const LAS unsigned char* vt, int lane, float off) {
    const int hi = lane >> 5, i16 = lane & 15, q = i16 >> 2, p = i16 & 3, blk = (lane >> 4) & 1;
    const LAS unsigned char* vb = vt + (4 * hi + q) * VP + (16 * blk + 4 * p) * 2;
    s16x4 lo[2][NDT], hh[2][NDT];
#pragma unroll
    for (int dt = 0; dt < NDT; ++dt) { lo[0][dt] = vtr(vb + dt * 64); hh[0][dt] = vtr(vb + 8 * VP + dt * 64); }
    float sum = 0.f;
#pragma unroll
    for (int f = 0; f < 4; ++f) {
        if (f + 1 < 4) {
#pragma unroll
            for (int dt = 0; dt < NDT; ++dt) { lo[(f + 1) & 1][dt] = vtr(vb + (16 * (f + 1)) * VP + dt * 64); hh[(f + 1) & 1][dt] = vtr(vb + (16 * (f + 1) + 8) * VP + dt * 64); }
        }
        f32x16& sv = (f < 2) ? s0 : s1;
        const int b = 8 * (f & 1);
        float e[8];
#pragma unroll
        for (int j = 0; j < 8; ++j) { e[j] = __builtin_amdgcn_exp2f(HAS_OFF ? sv[b + j] + off : sv[b + j]); sum += e[j]; }
        u32x4 w; w.x = pk2(e[0], e[1]); w.y = pk2(e[2], e[3]); w.z = pk2(e[4], e[5]); w.w = pk2(e[6], e[7]);
        const bf16x8 pf = __builtin_bit_cast(bf16x8, w);
        __builtin_amdgcn_sched_barrier(0);
#pragma unroll
        for (int dt = 0; dt < NDT; ++dt) {
            const s16x4 l4 = lo[f & 1][dt], h4 = hh[f & 1][dt];
            const bf16x8 vf = {l4[0], l4[1], l4[2], l4[3], h4[0], h4[1], h4[2], h4[3]};
            o[dt] = MFMA32(vf, pf, o[dt]);
        }
        __builtin_amdgcn_sched_barrier(0);
    }
    l += sum;
}
DI u32x4 pair_swap16(u32x2 a, u32x2 b) {
    auto rx = __builtin_amdgcn_permlane32_swap(a.x, b.x, false, false);
    auto ry = __builtin_amdgcn_permlane32_swap(a.y, b.y, false, false);
    return (u32x4){rx[0], ry[0], rx[1], ry[1]};
}
constexpr int DF_K0 = 0, DF_K1 = 2 * 64 * KP, DF_V = 4 * 64 * KP, DF_VB = 64 * 320;
DI void diff_unit(Frame& F, int b, int h, int qt, float lam, float soff) {
    const int tid = F.tid, lane = F.lane, wid = F.wave, r32 = lane & 31, hi = lane >> 5, c = wid >> 2, wq = wid & 3;
    const int q0w = qt * 128 + wq * 32, qpos = q0w + r32;
    const bf16_t* zb = F.Z + (size_t)b * SEQ * LDZ;
    bf16x8 qf[4];
    { const bf16_t* qrow = zb + (size_t)qpos * LDZ + ZC_DQ + h * 128 + c * 64 + hi * 8;
#pragma unroll
      for (int cc = 0; cc < 4; ++cc) qf[cc] = *(const bf16x8*)(qrow + cc * 16); }
    f32x16 o[4];
#pragma unroll
    for (int dt = 0; dt < 4; ++dt) for (int i = 0; i < 16; ++i) o[dt][i] = 0.f;
    float m = -INFINITY, l = 0.f;
    const int NT = 2 * (qt + 1);
    const int krow = tid >> 3, kch = tid & 7, vrow = tid >> 4, vch = tid & 15;
    const bf16_t* kg = F.KD + ((size_t)(b * 16 + h * 2) * SEQ + krow) * 64 + kch * 8;
    const bf16_t* vg = F.VD + ((size_t)(b * 8 + h) * SEQ + vrow) * 128 + vch * 8;
    constexpr size_t K1O = (size_t)SEQ * 64;
    LAS unsigned char* const lk0 = F.lds + DF_K0 + krow * KP + kch * 16;
    LAS unsigned char* const lk1 = F.lds + DF_K1 + krow * KP + kch * 16;
    LAS unsigned char* const lv = F.lds + DF_V + vrow * 320 + vch * 16;
    u32x4 rk0, rk1, rv0, rv1;
    {
        rk0 = *(const u32x4*)(kg); rk1 = *(const u32x4*)(kg + K1O); rv0 = *(const u32x4*)(vg); rv1 = *(const u32x4*)(vg + 32 * 128);
        const u32x4 t1 = *(const u32x4*)(kg + K1O + 64 * 64);
        *(LAS u32x4*)lk0 = rk0; *(LAS u32x4*)lk1 = rk1; *(LAS u32x4*)(lk1 + 64 * KP) = t1; *(LAS u32x4*)lv = rv0; *(LAS u32x4*)(lv + 32 * 320) = rv1;
    }
    __syncthreads();
    f32x16 s0, s1;
    if (c == 1) qk_tile(s0, s1, F.lds + DF_K1, qf, r32, hi, soff);
    __syncthreads();
#define DF_SOFTMAX_PV(kt) do { \
        if (64 * (kt) + 63 > q0w) { \
            _Pragma("unroll") for (int i = 0; i < 16; ++i) { const int key = 64 * (kt) + crow(i, hi); \
                s0[i] = (key <= qpos) ? s0[i] : -INFINITY; s1[i] = (key + 32 <= qpos) ? s1[i] : -INFINITY; } \
        } \
        softmax_pv<4, 320, false>(s0, s1, l, o, F.lds + DF_V + ((kt) & 1) * DF_VB, lane, 0.f); } while (0)
#define DF_LOADS(kt) do { \
        if ((kt) + 1 < NT) { rk0 = *(const u32x4*)(kg + (size_t)((kt) + 1) * 4096); rv0 = *(const u32x4*)(vg + (size_t)((kt) + 1) * 8192); rv1 = *(const u32x4*)(vg + (size_t)((kt) + 1) * 8192 + 32 * 128); } \
        if ((kt) + 2 < NT) rk1 = *(const u32x4*)(kg + K1O + (size_t)((kt) + 2) * 4096); } while (0)
#define DF_STORES(kt) do { \
        if ((kt) + 1 < NT) { *(LAS u32x4*)(lk0 + (((kt) + 1) & 1) * 64 * KP) = rk0; *(LAS u32x4*)(lv + (((kt) + 1) & 1) * DF_VB) = rv0; *(LAS u32x4*)(lv + (((kt) + 1) & 1) * DF_VB + 32 * 320) = rv1; } \
        if ((kt) + 2 < NT) *(LAS u32x4*)(lk1 + ((kt) & 1) * 64 * KP) = rk1; \
        __syncthreads(); } while (0)
    if (c == 0) {
        for (int kt = 0; kt < NT; ++kt) {
            DF_LOADS(kt);
            if (64 * kt <= q0w + 31) {
                qk_tile(s0, s1, F.lds + DF_K0 + (kt & 1) * 64 * KP, qf, r32, hi, soff);
                DF_SOFTMAX_PV(kt);
            }
            DF_STORES(kt);
        }
    } else {
        for (int kt = 0; kt < NT; ++kt) {
            DF_LOADS(kt);
            if (64 * kt <= q0w + 31) DF_SOFTMAX_PV(kt);
            if ((kt + 1 < NT) && (64 * (kt + 1) <= q0w + 31)) qk_tile(s0, s1, F.lds + DF_K1 + ((kt + 1) & 1) * 64 * KP, qf, r32, hi, soff);
            DF_STORES(kt);
        }
    }
#undef DF_LOADS
#undef DF_STORES
#undef DF_SOFTMAX_PV
    l = xhalf_sum(l);
    const float inv = 1.0f / l;
    LAS float* xb = (LAS float*)F.lds + wq * 4096;
    if (c == 1) {
        const float sc = lam * inv;
#pragma unroll
        for (int dt = 0; dt < 4; ++dt)
#pragma unroll
            for (int i = 0; i < 16; ++i) xb[(dt * 16 + i) * 64 + lane] = o[dt][i] * sc;
    }
    __syncthreads();
    if (c == 0) {
        float ss = 0.f;
#pragma unroll
        for (int dt = 0; dt < 4; ++dt)
#pragma unroll
            for (int i = 0; i < 16; ++i) { const float v = o[dt][i] * inv - xb[(dt * 16 + i) * 64 + lane]; o[dt][i] = v; ss += v * v; }
        ss += __shfl_xor(ss, 32);
        const float rs = rsqrtf(ss * (1.f / 128.f) + NORM_EPS) * 0.8f;
        bf16_t* yrow = F.YA + ((size_t)b * SEQ + qpos) * 1024 + h * 128;
#pragma unroll
        for (int dt = 0; dt < 4; ++dt)
#pragma unroll
            for (int ap = 0; ap < 4; ap += 2) { u32x2 w[2];
#pragma unroll
                for (int q = 0; q < 2; ++q) { const int a = ap + q; const int dv = 32 * dt + 8 * a + 4 * hi; const f32x4 g = *(const f32x4*)(F.subln + dv);
                    w[q].x = pk2(o[dt][4 * a] * rs * g[0], o[dt][4 * a + 1] * rs * g[1]); w[q].y = pk2(o[dt][4 * a + 2] * rs * g[2], o[dt][4 * a + 3] * rs * g[3]); }
                *(u32x4*)(yrow + 32 * dt + 8 * ap + 8 * hi) = pair_swap16(w[0], w[1]); }
    }
    __syncthreads();
}

DI void cmp_gemm2(Frame& F, int c) {
    const int kv = c >> 3, m0 = (c & 7) * 256, tid = F.tid;
    __syncthreads();
    LAS float* w2s = (LAS float*)F.lds;
    for (int i = tid; i < 256 * 64 / 4; i += NTHREADS) *((LAS f32x4*)w2s + i) = *((const f32x4*)(F.cw2 + (size_t)kv * 256 * 64) + i);
    __syncthreads();
    const int qd = tid & 3;
#pragma unroll 1
    for (int pass = 0; pass < 2; ++pass) {
        const int m = m0 + pass * 128 + (tid >> 2);
        const bf16_t* hr = F.HID + ((size_t)kv * 2048 + m) * 256;
        float acc[16];
#pragma unroll
        for (int n = 0; n < 16; ++n) acc[n] = 0.f;
#pragma unroll 1
        for (int k8 = 0; k8 < 32; ++k8) {
            const u32x4 w = *(const u32x4*)(hr + k8 * 8);
            const float a[8] = {bflo(w.x), bfhi(w.x), bflo(w.y), bfhi(w.y), bflo(w.z), bfhi(w.z), bflo(w.w), bfhi(w.w)};
#pragma unroll
            for (int kk = 0; kk < 8; ++kk) {
                const LAS f32x4* wr = (const LAS f32x4*)(w2s + (k8 * 8 + kk) * 64 + qd * 16);
#pragma unroll
                for (int n4 = 0; n4 < 4; ++n4) { const f32x4 wv = wr[n4]; acc[4 * n4] += a[kk] * wv[0]; acc[4 * n4 + 1] += a[kk] * wv[1]; acc[4 * n4 + 2] += a[kk] * wv[2]; acc[4 * n4 + 3] += a[kk] * wv[3]; }
            }
        }
        if (kv == 0) {
            float ss = 0.f;
#pragma unroll
            for (int n = 0; n < 16; ++n) ss += acc[n] * acc[n];
            ss += __shfl_xor(ss, 1); ss += __shfl_xor(ss, 2);
            const float rs = rsqrtf(ss * (1.f / 64.f) + NORM_EPS);
#pragma unroll
            for (int n = 0; n < 16; ++n) acc[n] *= rs * F.nkn[qd * 16 + n];
        }
        const bool padrow = (m & 255) == 255;
        bf16_t* orow = (kv ? F.VC : F.KC) + (size_t)m * 64 + qd * 16;
#pragma unroll
        for (int n8 = 0; n8 < 2; ++n8) { u32x4 o; o.x = pk2(acc[8 * n8], acc[8 * n8 + 1]); o.y = pk2(acc[8 * n8 + 2], acc[8 * n8 + 3]); o.z = pk2(acc[8 * n8 + 4], acc[8 * n8 + 5]); o.w = pk2(acc[8 * n8 + 6], acc[8 * n8 + 7]);
            if (padrow) o = (u32x4){0u, 0u, 0u, 0u};
            *(u32x4*)(orow + n8 * 8) = o; }
    }
    __syncthreads();
}

constexpr int NS_BUF = 64 * KP + 64 * 192;
constexpr int NS_SLAB = 2 * NS_BUF;
constexpr int NS_SELM = NS_SLAB + 8 * 32 * 65 * 4;
template <int BR> DI void nsa_branch(Frame& F, unsigned long long tiles, const bf16_t* kptr, size_t kpitch, const bf16_t* vptr, size_t vpitch,
                                     const bf16x8* qf, float& m, float& l, f32x16* o, int qpos, unsigned long long mymask, float inv_l, float soff) {
    const int tid = F.tid, lane = F.lane, r32 = lane & 31, hi = lane >> 5;
    const int row = tid >> 3, ch = tid & 7;
    if (tiles == 0ull) return;
    u32x4 rk, rv;
    unsigned long long rest = tiles;
    int kt = __builtin_ctzll(rest); rest &= rest - 1;
    rk = *(const u32x4*)(kptr + ((size_t)kt * 64 + row) * kpitch + ch * 8); rv = *(const u32x4*)(vptr + ((size_t)kt * 64 + row) * vpitch + ch * 8);
    int buf = 0;
    { LAS unsigned char* bb = F.lds; *(LAS u32x4*)(bb + row * KP + ch * 16) = rk; *(LAS u32x4*)(bb + 64 * KP + row * 192 + ch * 16) = rv; }
    __syncthreads();
    for (;;) {
        const bool more = rest != 0ull;
        int ktn = 0;
        if (more) { ktn = __builtin_ctzll(rest); rest &= rest - 1;
            rk = *(const u32x4*)(kptr + ((size_t)ktn * 64 + row) * kpitch + ch * 8); rv = *(const u32x4*)(vptr + ((size_t)ktn * 64 + row) * vpitch + ch * 8); }
        const LAS unsigned char* bb = F.lds + buf * NS_BUF;
        f32x16 s0, s1;
        const bool selbit = BR == 2 ? ((mymask >> kt) & 1ull) != 0ull : true;
        qk_tile(s0, s1, bb, qf, r32, hi, selbit ? soff : -INFINITY);
        const int t0 = qpos - r32;
        bool full;
        if (BR <= 1) full = 16 * (64 * kt + 63) + 31 <= t0;
        else if (BR == 2) full = 64 * kt + 63 <= t0;
        else full = (64 * kt + 63 <= t0) && (t0 + 31 - 64 * kt < 512);
        if (!full) {
#pragma unroll
            for (int i = 0; i < 16; ++i) {
                const int k0 = 64 * kt + crow(i, hi), k1 = k0 + 32;
                bool v0, v1;
                if (BR <= 1) { v0 = 16 * k0 + 31 <= qpos; v1 = 16 * k1 + 31 <= qpos; }
                else if (BR == 2) { v0 = k0 <= qpos; v1 = k1 <= qpos; }
                else { const int d0 = qpos - k0, d1 = qpos - k1; v0 = d0 >= 0 && d0 < 512; v1 = d1 >= 0 && d1 < 512; }
                s0[i] = v0 ? s0[i] : -INFINITY; s1[i] = v1 ? s1[i] : -INFINITY;
            }
        }
        if (BR == 0) {
            f32x16* none = nullptr;
            online_step<0>(s0, s1, m, l, none, true);
        } else if (BR == 1) {
            online_step<2>(s0, s1, m, l, o, true);
            LAS float* slab = (LAS float*)(F.lds + NS_SLAB) + F.wave * (32 * 65) + r32 * 65;
#pragma unroll
            for (int t = 0; t < 2; ++t)
#pragma unroll
                for (int a = 0; a < 4; ++a) {
                    const f32x16& s = t ? s1 : s0;
                    const int J = 16 * kt + 8 * t + 2 * a + hi;
                    const float gsum = (s[4 * a] + s[4 * a + 1]) + (s[4 * a + 2] + s[4 * a + 3]);
                    atomicAdd((float*)(slab + J), gsum);
                    atomicAdd((float*)(slab + J + 1), s[4 * a + 3]);
                }
            pv_tile<2, 192>(o, bb + 64 * KP, s0, s1, lane);
        } else {
            softmax_pv<2, 192, false>(s0, s1, l, o, bb + 64 * KP, lane, 0.f);
        }
        if (more) { LAS unsigned char* nb = F.lds + (buf ^ 1) * NS_BUF; *(LAS u32x4*)(nb + row * KP + ch * 16) = rk; *(LAS u32x4*)(nb + 64 * KP + row * 192 + ch * 16) = rv; }
        __syncthreads();
        if (!more) break;
        kt = ktn; buf ^= 1;
    }
}
DI void nsa_unit(Frame& F, int b, int g, int tt, float soff) {
    const int lane = F.lane, wid = F.wave, r32 = lane & 31, hi = lane >> 5;
    const int t0 = tt * 32, qpos = t0 + r32, hn = g * 8 + wid, qblk = t0 >> 6;
    const size_t tok = (size_t)b * SEQ + qpos;
    const bf16_t* zb = F.Z + (size_t)b * SEQ * LDZ;
    const bf16_t* zr = F.Z + tok * LDZ;
    bf16x8 qf[4], qp0;
    { const bf16_t* qrow = zr + ZC_NQ + hn * 64 + hi * 8;
#pragma unroll
      for (int cc = 0; cc < 4; ++cc) qf[cc] = *(const bf16x8*)(qrow + cc * 16);
      qp0 = *(const bf16x8*)(F.QP + (tok * 16 + hn) * 16 + hi * 8); }
    const float g0 = sigmoidf_(bf2f(zr[ZC_NG + hn * 3 + 0])), g1 = sigmoidf_(bf2f(zr[ZC_NG + hn * 3 + 1])), g2 = sigmoidf_(bf2f(zr[ZC_NG + hn * 3 + 2]));
    f32x16 o[2];
#pragma unroll
    for (int dt = 0; dt < 2; ++dt) for (int i = 0; i < 16; ++i) o[dt][i] = 0.f;
    LAS f32x4* stg = (LAS f32x4*)(F.lds + NS_SLAB + wid * 8192) + lane;
    { LAS float* slab = (LAS float*)(F.lds + NS_SLAB) + wid * (32 * 65);
      for (int i = lane; i < 32 * 65; i += 64) slab[i] = 0.f; }
    const int ncb = min(t0 / 16 + 1, 255), nct = (ncb + 63) >> 6;
    const unsigned long long ctiles = (1ull << nct) - 1ull;
    const bf16_t* kc = F.KC + (size_t)(b * 2 + g) * 256 * 64; const bf16_t* vc = F.VC + (size_t)(b * 2 + g) * 256 * 64;
    {
        bf16x8 qpl[4] = {qp0, qf[1], qf[2], qf[3]};
        float m = -INFINITY, l = 0.f;
        nsa_branch<1>(F, ctiles, kc, 64, vc, 64, qpl, m, l, o, qpos, 0ull, 0.f, soff);
        l = xhalf_sum(l);
        const float inv = l > 0.f ? 1.0f / l : 0.f;
#pragma unroll
        for (int dt = 0; dt < 2; ++dt) for (int i = 0; i < 16; ++i) o[dt][i] *= inv;
        if (lane < 32) ((LAS float*)(F.lds + NS_SELM + 256))[wid * 32 + lane] = inv;
    }
    __syncthreads();
    {
        const LAS float* slabs = (const LAS float*)(F.lds + NS_SLAB);
        LAS unsigned long long* selm = (LAS unsigned long long*)(F.lds + NS_SELM);
#pragma unroll 1
        for (int tk = 0; tk < 4; ++tk) {
            const int token = 4 * wid + tk, j = lane;
            float v = 0.f;
#pragma unroll
            for (int w = 0; w < 8; ++w) v += slabs[w * (32 * 65) + token * 65 + j] * ((const LAS float*)(F.lds + NS_SELM + 256))[w * 32 + token];
            const bool valid = j <= qblk, forced = (j == 0) || (j == qblk) || (j == qblk - 1);
            const float score = valid ? v + (forced ? 1e4f : 0.f) : -1.0f;
            int rank = 0;
#pragma unroll
            for (int jj = 0; jj < 64; ++jj) { const float so = __builtin_bit_cast(float, __builtin_amdgcn_readlane(__builtin_bit_cast(int, score), jj));
                rank += (so > score || (so == score && jj < j)) ? 1 : 0; }
            const unsigned long long msk = __ballot(rank < 16);
            if (lane == 0) selm[token] = msk;
        }
    }
    __syncthreads();
    unsigned long long mymask, uni = 0ull;
    { const LAS unsigned long long* selm = (const LAS unsigned long long*)(F.lds + NS_SELM);
      mymask = selm[r32];
      unsigned long long u = mymask;
#pragma unroll
      for (int of = 1; of < 32; of <<= 1) { const unsigned lo = __shfl_xor((unsigned)u, of), hh = __shfl_xor((unsigned)(u >> 32), of); u |= ((unsigned long long)hh << 32) | lo; }
      const unsigned ulo = __builtin_amdgcn_readfirstlane((unsigned)u), uhi = __builtin_amdgcn_readfirstlane((unsigned)(u >> 32));
      uni = ((unsigned long long)uhi << 32) | ulo; }
    const unsigned long long validm = (qblk >= 63) ? ~0ull : ((1ull << (qblk + 1)) - 1ull);
#pragma unroll
    for (int dt = 0; dt < 2; ++dt)
#pragma unroll
        for (int a = 0; a < 4; ++a) { stg[(dt * 4 + a) * 64] = (f32x4){g0 * o[dt][4 * a], g0 * o[dt][4 * a + 1], g0 * o[dt][4 * a + 2], g0 * o[dt][4 * a + 3]};
            o[dt][4 * a] = 0.f; o[dt][4 * a + 1] = 0.f; o[dt][4 * a + 2] = 0.f; o[dt][4 * a + 3] = 0.f; }
    {
        float m = -INFINITY, l = 0.f;
        nsa_branch<2>(F, uni & validm, F.NKV + (size_t)(0 * 8 + b * 2 + g) * SEQ * 64, 64, F.NKV + (size_t)(1 * 8 + b * 2 + g) * SEQ * 64, 64, qf, m, l, o, qpos, mymask, 0.f, soff);
        l = xhalf_sum(l);
        const float sc = l > 0.f ? g1 / l : 0.f;
#pragma unroll
        for (int dt = 0; dt < 2; ++dt)
#pragma unroll
            for (int a = 0; a < 4; ++a) { f32x4 v = stg[(dt * 4 + a) * 64];
                v[0] += sc * o[dt][4 * a]; v[1] += sc * o[dt][4 * a + 1]; v[2] += sc * o[dt][4 * a + 2]; v[3] += sc * o[dt][4 * a + 3]; stg[(dt * 4 + a) * 64] = v;
                o[dt][4 * a] = 0.f; o[dt][4 * a + 1] = 0.f; o[dt][4 * a + 2] = 0.f; o[dt][4 * a + 3] = 0.f; }
    }
    {
        const int lo_key = max(0, t0 - 511), kt_lo = lo_key >> 6, kt_hi = (t0 + 31) >> 6;
        const unsigned long long hm = (kt_hi >= 63) ? ~0ull : ((1ull << (kt_hi + 1)) - 1ull);
        const unsigned long long wtiles = hm & ~((1ull << kt_lo) - 1ull);
        float m = -INFINITY, l = 0.f;
        nsa_branch<3>(F, wtiles, F.NKV + (size_t)(2 * 8 + b * 2 + g) * SEQ * 64, 64, F.NKV + (size_t)(3 * 8 + b * 2 + g) * SEQ * 64, 64, qf, m, l, o, qpos, 0ull, 0.f, soff);
        l = xhalf_sum(l);
        const float sc = l > 0.f ? g2 / l : 0.f;
#pragma unroll
        for (int dt = 0; dt < 2; ++dt)
#pragma unroll
            for (int a = 0; a < 4; ++a) { const f32x4 v = stg[(dt * 4 + a) * 64];
                o[dt][4 * a] = v[0] + sc * o[dt][4 * a]; o[dt][4 * a + 1] = v[1] + sc * o[dt][4 * a + 1]; o[dt][4 * a + 2] = v[2] + sc * o[dt][4 * a + 2]; o[dt][4 * a + 3] = v[3] + sc * o[dt][4 * a + 3]; }
    }
    bf16_t* yrow = F.YB + tok * 1024 + hn * 64;
#pragma unroll
    for (int dt = 0; dt < 2; ++dt)
#pragma unroll
        for (int ap = 0; ap < 4; ap += 2) { u32x2 w[2];
#pragma unroll
            for (int q = 0; q < 2; ++q) { const int a = ap + q; w[q].x = pk2(o[dt][4 * a], o[dt][4 * a + 1]); w[q].y = pk2(o[dt][4 * a + 2], o[dt][4 * a + 3]); }
            *(u32x4*)(yrow + 32 * dt + 8 * ap + 8 * hi) = pair_swap16(w[0], w[1]); }
    __syncthreads();
}

DI void mk_frame(Frame& F, const Params& prm, unsigned char* lds_raw_) {
    F.lds = (LAS unsigned char*)lds_raw_;
    F.tid = threadIdx.x; F.lane = F.tid & 63; F.wave = __builtin_amdgcn_readfirstlane(F.tid >> 6);
    F.G = gridDim.x; F.bid = blockIdx.x; F.vcu = (F.G % 8 == 0) ? (F.bid % 8) * (F.G / 8) + F.bid / 8 : F.bid;
    F.x = prm.in[0]; F.p = prm.in[1]; F.pos = (const int*)prm.in[2]; F.norm_mix = prm.in[3]; F.w_in = prm.in[4]; F.dqn = prm.in[5]; F.dkn = prm.in[6];
    F.dlam = prm.in[7]; F.subln = prm.in[8]; F.nqn = prm.in[9]; F.nkn = prm.in[10]; F.cpos = prm.in[11]; F.cw1 = prm.in[12]; F.cw2 = prm.in[13];
    F.wpd = prm.in[14]; F.wpn = prm.in[15]; F.wout = prm.in[16]; F.norm_mlp = prm.in[17]; F.wup = prm.in[18]; F.wdn = prm.in[19]; F.wple = prm.in[20];
    F.norm_ple = prm.in[21]; F.wgate = prm.in[22]; F.out = prm.out;
    unsigned char* ws = prm.ws; unsigned char* dob = (unsigned char*)prm.out;
    F.WIN = (bf16_t*)(ws + WS_WIN); F.WUP = (bf16_t*)(ws + WS_WUP); F.WDN = (bf16_t*)(ws + WS_WDN); F.WOUT = (bf16_t*)(ws + WS_WOUT); F.WGATE = (bf16_t*)(ws + WS_WGATE);
    F.WPD = (bf16_t*)(ws + WS_WPD); F.WPN = (bf16_t*)(ws + WS_WPN); F.WPLE = (bf16_t*)(ws + WS_WPLE); F.WC1 = (bf16_t*)(ws + WS_WC1);
    F.H = (bf16_t*)(ws + WS_H); F.Z = (bf16_t*)(ws + WS_Z); F.PE = (bf16_t*)(ws + WS_PE); F.PB = (bf16_t*)(ws + WS_PB); F.X1B = (bf16_t*)(ws + WS_X1B); F.HIDN = (bf16_t*)(ws + WS_HID);
    F.SSQ1 = (float*)(ws + WS_SSQ); F.SSQ2 = F.SSQ1 + T; F.SSQPE = F.SSQ1 + 2 * T;
    F.YA = (bf16_t*)(dob + DO_YA); F.YB = (bf16_t*)(dob + DO_YB); F.BLK = (bf16_t*)(dob + DO_BLK); F.HID = (bf16_t*)(dob + DO_HID); F.KC = (bf16_t*)(dob + DO_KC);
    F.VC = (bf16_t*)(dob + DO_VC); F.QP = (bf16_t*)(dob + DO_QP); F.ROPE = (float*)(dob + DO_ROPE);
    F.KD = (bf16_t*)(dob + DO_KD); F.VD = (bf16_t*)(ws + WS_H); F.NKV = (bf16_t*)(ws + WS_H + 32 * MiB);
}
#define XB_TMO      128
#define XB_XCNT(j)  (256  + 64 * (j))
#define XB_XSUB(j)  (1280 + 64 * (j))
#define XB_XGEN(j)  (2304 + 64 * (j))
#define XB_TOP      3328
#define XB_TOPGEN   3392
#define XCD_BAR_WORDS 3456
#define XB_SPIN_CAP (1u << 18)

__device__ __forceinline__ unsigned xb_ld(unsigned* p)              { return __hip_atomic_load(p, __ATOMIC_RELAXED, __HIP_MEMORY_SCOPE_AGENT); }
__device__ __forceinline__ unsigned xb_add(unsigned* p, unsigned v) { return __hip_atomic_fetch_add(p, v, __ATOMIC_RELAXED, __HIP_MEMORY_SCOPE_AGENT); }
__device__ __forceinline__ unsigned xb_xcc_id() { return (unsigned)__builtin_amdgcn_s_getreg((3 << 11) | 20) & 0xFu; }
#define XB_SPIN(cond, bar) do { unsigned _sp = 0; while (cond) { __builtin_amdgcn_s_sleep(1); \
    if ((++_sp & 255u) == 0u) { if (xb_ld(&(bar)[XB_TMO])) break; if (_sp > XB_SPIN_CAP) { atomicAdd(&(bar)[XB_TMO], 1u); break; } } } } while (0)

struct XcdBarrier {
    unsigned* bar; unsigned x;
    volatile LAS unsigned* st;
};

__device__ __forceinline__ XcdBarrier xcd_barrier_post(unsigned* bar, volatile LAS unsigned* st) {
    XcdBarrier b; b.bar = bar; b.x = xb_xcc_id(); b.st = st;
    if (threadIdx.x == 0) (void)xb_add(&bar[XB_XCNT(b.x)], 1u);
    return b;
}
__device__ __forceinline__ void xcd_barrier_complete(unsigned* bar, unsigned x, unsigned& nloc, unsigned& nx) {
    const unsigned G = gridDim.x * gridDim.y * gridDim.z;
    unsigned sum, cnt, mine, sp = 0u;
    for (;;) {
        sum = 0u; cnt = 0u; mine = 0u;
#pragma unroll
        for (unsigned j = 0; j < 16; ++j) { const unsigned c = xb_ld(&bar[XB_XCNT(j)]); sum += c; cnt += (c > 0u) ? 1u : 0u; mine = (j == x) ? c : mine; }
        if (sum == G) break;
        __builtin_amdgcn_s_sleep(1);
        if ((++sp & 255u) == 0u) { if (xb_ld(&bar[XB_TMO])) break; if (sp > XB_SPIN_CAP) { atomicAdd(&bar[XB_TMO], 1u); break; } }
    }
    nloc = mine > 0u ? mine : 1u; nx = cnt > 0u ? cnt : 1u;
}

__device__ __forceinline__ void xcd_barrier(const XcdBarrier& b) {
    asm volatile("s_waitcnt vmcnt(0)" ::: "memory");
    __syncthreads();
    if (threadIdx.x == 0) {
        unsigned* bar = b.bar;
        __builtin_amdgcn_s_waitcnt(0);
        unsigned nloc = b.st[0], nx = b.st[1];
        if (nloc == 0u) { xcd_barrier_complete(bar, b.x, nloc, nx); b.st[0] = nloc; b.st[1] = nx; }
        const unsigned old = xb_add(&bar[XB_XSUB(b.x)], 1u);
        const unsigned gen = old / nloc;
        if (old + 1u == (gen + 1u) * nloc) {
            __builtin_amdgcn_fence(__ATOMIC_RELEASE, "agent");
            asm volatile("s_waitcnt vmcnt(0)" ::: "memory");
            const unsigned og = xb_add(&bar[XB_TOP], 1u);
            const unsigned tg = og / nx;
            if (og + 1u == (tg + 1u) * nx) xb_add(&bar[XB_TOPGEN], 1u);
            else XB_SPIN(xb_ld(&bar[XB_TOPGEN]) == tg, bar);
            __builtin_amdgcn_fence(__ATOMIC_ACQUIRE, "agent");
            xb_add(&bar[XB_XGEN(b.x)], 1u);
            asm volatile("s_waitcnt vmcnt(0)" ::: "memory");
        } else {
            XB_SPIN(xb_ld(&bar[XB_XGEN(b.x)]) == gen, bar);
            __builtin_amdgcn_fence(__ATOMIC_ACQUIRE, "agent");
            asm volatile("s_waitcnt vmcnt(0)" ::: "memory");
        }
    }
    __syncthreads();
}


constexpr int NPHASE = 11;
#ifndef REP_MASK
#define REP_MASK 0
#endif
__global__ void __launch_bounds__(NTHREADS, 2) fwd_megakernel(Params prm, int ph_lo, int ph_hi) {
    extern __shared__ __attribute__((aligned(16))) unsigned char lds_raw[];
    cg::grid_group grid = cg::this_grid();
    for (int u = threadIdx.x; u < (LDS_BYTES - LDSCTL_OFF) / 4; u += NTHREADS) ((LAS unsigned*)((LAS unsigned char*)lds_raw + LDSCTL_OFF))[u] = 0u;
    __syncthreads();
    XcdBarrier xbar = xcd_barrier_post((unsigned*)(prm.ws + WS_CTL), (volatile LAS unsigned*)((LAS unsigned char*)lds_raw + MISC_OFF) + 8);
#define IN(k) (ph_lo <= (k) && (k) < ph_hi)
#define REP(k) for (int rep_ = 0; rep_ < (((REP_MASK) >> (k)) & 1) + 1; ++rep_)
#ifndef SYNC_REP
#define SYNC_REP 1
#endif
#define SEAM(k) do { if (IN(k) && IN((k) + 1)) { for (int sr_ = 0; sr_ < SYNC_REP; ++sr_) { if (ph_lo < 0) grid.sync(); else xcd_barrier(xbar); } } } while (0)
#define FRAME Frame F; mk_frame(F, prm, lds_raw); const int gw = F.vcu * NWAVES + F.wave, NGW = F.G * NWAVES; (void)gw; (void)NGW

    if (IN(0)) REP(0) { FRAME; p0_prologue(F); }
    SEAM(0);
    if (IN(1)) REP(1) { FRAME;
        pg8::Gemm g{F.H, F.WIN, T, LDZ, DM}; pg8::StaticOrder S; S.init(T, LDZ, F.G, F.bid);
        pg8::EpiBf16<0, false> E{F.Z, LDZ, nullptr, nullptr};
        pg8::gemm_phase<pg8::EpiBf16<0, false>, pg8::StaticOrder, true, true>(F.lds, g, S, E);
    }
    SEAM(1);
    if (IN(2)) { FRAME; p2a_blocks(F); }
    SEAM(2);
    if (IN(3)) { FRAME;
        if (F.G > 32) {
            if (F.bid < 16) {
                pg8::Gemm g{F.BLK, F.WC1, 4096, 256, 2048}; pg8::CmpOrder S{F.bid};
                pg8::EpiBf16<2, true> E{F.HID, 256, nullptr, nullptr};
                pg8::gemm_phase<pg8::EpiBf16<2, true>, pg8::CmpOrder, false, true>(F.lds, g, S, E);
                cmp_gemm2(F, F.bid);
            } else {
                p2_postprocess(F, (F.bid - 16) * NWAVES + F.wave, (F.G - 16) * NWAVES);
            }
        } else {
            for (int c = F.bid; c < 16; c += F.G) {
                pg8::Gemm g{F.BLK, F.WC1, 4096, 256, 2048}; pg8::CmpOrder S{c};
                pg8::EpiBf16<2, true> E{F.HID, 256, nullptr, nullptr};
                pg8::gemm_phase<pg8::EpiBf16<2, true>, pg8::CmpOrder, false, true>(F.lds, g, S, E);
                cmp_gemm2(F, c);
            }
            p2_postprocess(F, F.bid * NWAVES + F.wave, NGW);
        }
    }
    SEAM(3);
    if (IN(4)) { FRAME;
        float lam;
        { const float a = F.dlam[F.lane] * F.dlam[64 + F.lane], bq = F.dlam[128 + F.lane] * F.dlam[192 + F.lane];
          lam = __expf(wave_sum(a)) - __expf(wave_sum(bq)) + 0.2f; }
        float soff;
        { float gq = fabsf(F.dqn[F.lane]), gk = fabsf(F.dkn[F.lane]);
#pragma unroll
          for (int of = 1; of < 64; of <<= 1) { gq = fmaxf(gq, __shfl_xor(gq, of)); gk = fmaxf(gk, __shfl_xor(gk, of)); }
          const float bnd = 64.f * SC_L2E * gq * gk; soff = bnd > 100.f ? 60.f - bnd : 0.f; }
        for (int i = F.vcu; i < 1024 * (((REP_MASK >> 4) & 1) + 1); i += F.G) {
            const int c = i & 255, round = (i >> 8) & 3, j = c & 31, bh = (c >> 5) * 4 + round;
            const int qt = (round & 1) ? j : 31 - j;
            diff_unit(F, bh >> 3, bh & 7, qt, lam, soff);
        }
    }
    if (IN(5)) { FRAME;
        float soff;
        { float gq = fabsf(F.nqn[F.lane]), gk = fabsf(F.nkn[F.lane]);
#pragma unroll
          for (int of = 1; of < 64; of <<= 1) { gq = fmaxf(gq, __shfl_xor(gq, of)); gk = fmaxf(gk, __shfl_xor(gk, of)); }
          const float bnd = 64.f * SC_L2E * gq * gk; soff = bnd > 100.f ? 60.f - bnd : 0.f; }
        for (int i = F.vcu; i < 1024 * (((REP_MASK >> 5) & 1) + 1); i += F.G) {
            const int c = i & 255, round = (i >> 8) & 3, s = c & 31, bg = c >> 5;
            const int tt = round == 0 ? 127 - s : round == 1 ? 64 + s : round == 2 ? 63 - s : s;
            nsa_unit(F, bg >> 1, bg & 1, tt, soff);
        }
    }
    SEAM(5);
    if (IN(6)) REP(6) { FRAME;
        { pg8::Gemm g{F.YA, F.WPD, T, DM, 1024}; pg8::StaticOrder S; S.init(T, DM, F.G, F.bid);
          pg8::EpiGate<false> E{F.H, DM, F.Z + ZC_GA, LDZ};
          pg8::gemm_phase<pg8::EpiGate<false>, pg8::StaticOrder, true, true>(F.lds, g, S, E); }
        { pg8::Gemm g{F.YB, F.WPN, T, DM, 1024}; pg8::StaticOrder S; S.init(T, DM, F.G, F.bid);
          pg8::EpiGate<true> E{F.H, DM, F.Z + ZC_GB, LDZ};
          pg8::gemm_phase<pg8::EpiGate<true>, pg8::StaticOrder, true, true>(F.lds, g, S, E); }
    }
    SEAM(6);
    if (IN(7)) { FRAME;
        for (int e = gw * 64 + F.lane; e < T * PLE / 8; e += NGW * 64) {
            const f32x4 a = *((const f32x4*)F.p + 2 * e), bq = *((const f32x4*)F.p + 2 * e + 1);
            u32x4 o; o.x = pk2(a[0], a[1]); o.y = pk2(a[2], a[3]); o.z = pk2(bq[0], bq[1]); o.w = pk2(bq[2], bq[3]);
            *((u32x4*)F.PB + e) = o;
        }
        pg8::Gemm g{F.H, F.WOUT, T, DM, DM}; pg8::StaticOrder S; S.init(T, DM, F.G, F.bid);
        pg8::EpiRes E{F.x, F.out, DM, F.X1B, F.SSQ1};
        pg8::gemm_phase<pg8::EpiRes, pg8::StaticOrder, true, true>(F.lds, g, S, E);
    }
    SEAM(7);
    if (IN(8)) REP(8) { FRAME;
        pg8::Gemm g{F.X1B, F.WUP, T, DFF, DM}; pg8::StaticOrder S; S.init(T, DFF, F.G, F.bid);
        pg8::EpiBf16<1, false, true, false> E{F.HIDN, DFF, F.SSQ1, nullptr};
        pg8::gemm_phase<pg8::EpiBf16<1, false, true, false>, pg8::StaticOrder, true, true>(F.lds, g, S, E);
    }
    SEAM(8);
    if (IN(9)) { FRAME;
        { pg8::Gemm g{F.HIDN, F.WDN, T, DM, DFF}; pg8::StaticOrder S; S.init(T, DM, F.G, F.bid);
          pg8::EpiRes E{F.out, F.out, DM, F.H, F.SSQ2};
          pg8::gemm_phase<pg8::EpiRes, pg8::StaticOrder, true, true>(F.lds, g, S, E); }
        { pg8::Gemm g{F.PB, F.WPLE, T, DM, PLE}; pg8::StaticOrder S; S.init(T, DM, F.G, F.bid);
          pg8::EpiBf16<0, false, false, true> E{F.PE, DM, nullptr, F.SSQPE};
          pg8::gemm_phase<pg8::EpiBf16<0, false, false, true>, pg8::StaticOrder, true, true>(F.lds, g, S, E); }
    }
    SEAM(9);
    if (IN(10)) { FRAME;
        pg8::Gemm g{F.H, F.WGATE, T, DM, DM}; pg8::StaticOrder S; S.init(T, DM, F.G, F.bid);
        pg8::EpiFinal E{F.out, F.out, DM, F.PE, F.SSQ2, F.SSQPE, F.norm_ple};
        pg8::gemm_phase<pg8::EpiFinal, pg8::StaticOrder, true, true>(F.lds, g, S, E);
    }
#undef IN
#undef SEAM
#undef REP
#undef FRAME
}

#ifndef MK_PER_PHASE
#define MK_PER_PHASE 0
#endif
extern "C" void kernel_launch(void* const* d_in, const int* in_sizes, int n_in, void* d_out, int out_size, void* d_ws, size_t ws_size, hipStream_t stream) {
    static int grid = 0;
    if (grid == 0) {
        if (n_in != 23 || in_sizes[0] != T * DM || out_size != T * DM || ws_size < WS_END) {
            fprintf(stderr, "kernel_launch: unexpected shapes (n_in %d, in0 %d, out %d, ws %zu); nothing launched\n", n_in, n_in > 0 ? in_sizes[0] : -1, out_size, ws_size); grid = -1; return; }
        int dev = 0, cus = 0, per_cu = 0;
        hipGetDevice(&dev); hipDeviceGetAttribute(&cus, hipDeviceAttributeMultiprocessorCount, dev);
        if (hipFuncSetAttribute((const void*)fwd_megakernel, hipFuncAttributeMaxDynamicSharedMemorySize, LDS_BYTES) != hipSuccess) { fprintf(stderr, "kernel_launch: hipFuncSetAttribute failed\n"); grid = -1; return; }
        if (hipOccupancyMaxActiveBlocksPerMultiprocessor(&per_cu, (const void*)fwd_megakernel, NTHREADS, LDS_BYTES) != hipSuccess || per_cu < 1) { fprintf(stderr, "kernel_launch: occupancy query gives %d\n", per_cu); per_cu = 1; }
        (void)hipGetLastError();
        grid = cus * per_cu;
    }
    if (grid < 0) return;
    if (hipMemsetAsync((char*)d_ws + WS_CTL, 0, CTL_ZERO_BYTES, stream) != hipSuccess) { fprintf(stderr, "kernel_launch: hipMemsetAsync failed\n"); return; }
    Params prm{};
    for (int i = 0; i < 23; ++i) prm.in[i] = (const float*)d_in[i];
    prm.out = (float*)d_out; prm.ws = (unsigned char*)d_ws;
#if MK_PER_PHASE
    for (int ph = 0; ph < NPHASE; ++ph) { int lo = ph, hi = ph + 1; void* args[] = {&prm, &lo, &hi};
        hipLaunchCooperativeKernel((const void*)fwd_megakernel, dim3(grid), dim3(NTHREADS), args, LDS_BYTES, stream); }
#else
    int lo = 0, hi = NPHASE; void* args[] = {&prm, &lo, &hi};
    hipError_t e = hipLaunchCooperativeKernel((const void*)fwd_megakernel, dim3(grid), dim3(NTHREADS), args, LDS_BYTES, stream);
    if (e != hipSuccess) fprintf(stderr, "kernel_launch: cooperative launch failed: %s (grid %d)\n", hipGetErrorString(e), grid);
#endif
}
```

```cpp
#include <hip/hip_runtime.h>
#include <hip/hip_cooperative_groups.h>
#include <cstdio>
#include <cstdint>
namespace cg = cooperative_groups;

#define DI __device__ __forceinline__
#define LAS __attribute__((address_space(3)))
typedef unsigned short bf16_t;
typedef short bf16x8 __attribute__((ext_vector_type(8)));
typedef short s16x4 __attribute__((ext_vector_type(4)));
typedef float f32x2 __attribute__((ext_vector_type(2)));
typedef float f32x4 __attribute__((ext_vector_type(4)));
typedef float f32x16 __attribute__((ext_vector_type(16)));
typedef unsigned u32x2 __attribute__((ext_vector_type(2)));
typedef unsigned u32x4 __attribute__((ext_vector_type(4)));
typedef __bf16 bf16x2_t __attribute__((ext_vector_type(2)));

constexpr int BATCH = 4, SEQ = 4096, DM = 2048, T = BATCH * SEQ;
constexpr int INW = 9008, LDZ = 9216, DFF = 8192, PLE = 256;
constexpr int ZC_DQ = 0, ZC_DK = 1024, ZC_DV = 2048, ZC_NQ = 3072, ZC_KC = 4096, ZC_VC = 4224, ZC_KS = 4352, ZC_VS = 4480,
              ZC_KW = 4608, ZC_VW = 4736, ZC_NG = 4864, ZC_GA = 4912, ZC_GB = 6960;
constexpr float NORM_EPS = 1e-6f;
constexpr float SC_L2E = 0.125f * 1.4426950408889634f;
constexpr int NWAVES = 8, NTHREADS = 512;

constexpr size_t MiB = 1u << 20;
constexpr size_t WS_WIN = 0, WS_WPD = 36 * MiB, WS_WPN = 40 * MiB, WS_WOUT = 44 * MiB, WS_WC1 = 52 * MiB, WS_WUP = 54 * MiB, WS_WDN = 86 * MiB,
                 WS_WGATE = 118 * MiB, WS_WPLE = 126 * MiB, WS_H = 127 * MiB, WS_Z = 191 * MiB, WS_CTL = 511 * MiB, WS_END = 511 * MiB + 65536;
constexpr size_t WS_PB = 0, WS_SSQ = 8 * MiB, WS_PE = 16 * MiB, WS_X1B = WS_Z, WS_HID = WS_Z + 64 * MiB;
constexpr size_t DO_YA = 0, DO_YB = 32 * MiB, DO_BLK = 64 * MiB, DO_HID = 80 * MiB, DO_KC = 82 * MiB, DO_VC = 83 * MiB, DO_QP = 84 * MiB,
                 DO_ROPE = 92 * MiB, DO_KD = 93 * MiB;
constexpr int LDS_BYTES = 147456, RING_BYTES = 131072, LDSCTL_OFF = RING_BYTES, MISC_OFF = LDSCTL_OFF + 320;
constexpr size_t CTL_ZERO_BYTES = 16384;

DI unsigned pk2(float lo, float hi) { f32x2 v = {lo, hi}; bf16x2_t b = __builtin_convertvector(v, bf16x2_t); return __builtin_bit_cast(unsigned, b); }
DI float bf2f(unsigned short u) { return __uint_as_float(((unsigned)u) << 16); }
DI float bflo(unsigned u) { return __uint_as_float(u << 16); }
DI float bfhi(unsigned u) { return __uint_as_float(u & 0xffff0000u); }
DI float sigmoidf_(float x) { return __builtin_amdgcn_rcpf(1.0f + __builtin_amdgcn_exp2f(x * -1.4426950408889634f)); }
DI float wave_sum(float v) {
#pragma unroll
    for (int o = 1; o < 64; o <<= 1) v += __shfl_xor(v, o);
    return v;
}
#define LDS_WAIT() asm volatile("s_waitcnt lgkmcnt(0)" ::: "memory")
#define MFMA32(a, b, c) __builtin_amdgcn_mfma_f32_32x32x16_bf16((a), (b), (c), 0, 0, 0)
DI int crow(int r, int hi) { return (r & 3) + 8 * (r >> 2) + 4 * hi; }

namespace pg8 {
constexpr int BM = 256, BK = 64, HALF = 128, HTB = HALF * BK * 2, NXCD = 8, WGM = 3;
DI int lds_byte(int r, int c) { const int st = (r >> 4) * 2 + (c >> 5), rr = r & 15, cc = c & 31, ob = rr * 64 + cc * 2; return st * 1024 + (ob ^ (((ob >> 9) & 1) << 5)); }
DI void stage_rc(int b, int& R, int& C) { const int st = b / 1024, sb = b % 1024, swz = sb ^ (((sb >> 9) & 1) << 5); R = (st >> 1) * 16 + swz / 64; C = (st & 1) * 32 + (swz % 64) / 2; }
DI int perm32(int rho) { const int n = rho >> 4, i = rho & 15; return 8 * (i >> 2) + 4 * n + (i & 3); }

struct Unit { int pm, pn; };
struct Gemm { const bf16_t* A; const bf16_t* Bt; int M, N, K; };

struct StaticOrder {
    int nM, nN, nwg, G, c;
    DI void init(int M, int N, int G_, int c_) { nM = M / BM; nN = N / BM; nwg = nM * nN; G = G_; c = c_; }
    DI bool next(int i, Unit& u) const {
        const long L = (long)i * G + c; if (L >= nwg) return false;
        int wgid = (int)L; { const int q = nwg / NXCD, r = nwg % NXCD, xcd = wgid % NXCD, off = wgid / NXCD; wgid = (xcd < r ? xcd * (q + 1) : r * (q + 1) + (xcd - r) * q) + off; }
#ifndef PG8_NMAJOR
#define PG8_NMAJOR 1
#endif
        if (!PG8_NMAJOR) {
            const int nig = WGM * nN, gid = wgid / nig, fm = gid * WGM, gsz = (nM - fm) < WGM ? (nM - fm) : WGM;
            u.pm = fm + ((wgid % nig) % gsz); u.pn = (wgid % nig) / gsz;
        } else {
            const int nig = WGM * nM, gid = wgid / nig, fn = gid * WGM, gsz = (nN - fn) < WGM ? (nN - fn) : WGM;
            u.pn = fn + ((wgid % nig) % gsz); u.pm = (wgid % nig) / gsz;
        }
        return true;
    }
};
struct CmpOrder {
    int c;
    DI bool next(int i, Unit& u) const { if (i > 0 || c >= 16) return false; u.pm = c; u.pn = c >> 3; return true; }
};

template <class Epi, class Sched, bool ALIGN_EPI, bool SP2>
DI void gemm_phase(LAS unsigned char* lds, const Gemm g, const Sched& S, const Epi& E) {
    const int tid = threadIdx.x, wid = __builtin_amdgcn_readfirstlane(tid >> 6), lane = tid & 63, wr = wid >> 2, wc = wid & 3, fr = lane & 15, fq = lane >> 4;
    const int K = g.K, nt = K / BK;
    unsigned voffA[2], voffB[2];
#pragma unroll
    for (int i = 0; i < 2; ++i) { int R, C; stage_rc(tid * 16 + i * 8192, R, C); const int Rb = Epi::PERM ? ((R & ~31) + perm32(R & 31)) : R;
        voffA[i] = (unsigned)(R * K + C) * 2u; voffB[i] = (unsigned)(Rb * K + C) * 2u; }
    const size_t kstep = (size_t)(BK * 2);
    const size_t hstep = (size_t)HALF * K * 2;
    const size_t tstep = 2 * hstep;
    const unsigned ldsw = (unsigned)wid * 1024u;
    const int aoff = lds_byte(wr * 64 + fr, fq * 8), boff = lds_byte(wc * 32 + fr, fq * 8);
#define PG8_SA(b, h) (((b) * 2 + (h)) * HTB)
#define PG8_SB(b, h) ((4 + (b) * 2 + (h)) * HTB)
#define PG8_STAGE(bufoff, gbase, voff) do { _Pragma("unroll") for (int _i = 0; _i < 2; ++_i) \
        __builtin_amdgcn_global_load_lds((const unsigned*)((const char*)(gbase) + (voff)[_i]), (LAS unsigned*)(lds + (bufoff) + ldsw + _i * 8192), 16, 0, 0); } while (0)
#define PG8_LDA(dst, b, h) do { _Pragma("unroll") for (int m = 0; m < 4; ++m) _Pragma("unroll") for (int k = 0; k < 2; ++k) dst[m][k] = *(const LAS bf16x8*)(lds + PG8_SA(b, h) + aoff + m * 2048 + k * 1024); } while (0)
#define PG8_LDB(dst, b, h) do { _Pragma("unroll") for (int n = 0; n < 2; ++n) _Pragma("unroll") for (int k = 0; k < 2; ++k) dst[n][k] = *(const LAS bf16x8*)(lds + PG8_SB(b, h) + boff + n * 2048 + k * 1024); } while (0)
#define PG8_MMA(ai, bj, At, Bt) do { __builtin_amdgcn_s_setprio(1); _Pragma("unroll") for (int m = 0; m < 4; ++m) _Pragma("unroll") for (int n = 0; n < 2; ++n) _Pragma("unroll") for (int k = 0; k < 2; ++k) \
        acc[ai][bj][m][n] = __builtin_amdgcn_mfma_f32_16x16x32_bf16(Bt[n][k], At[m][k], acc[ai][bj][m][n], 0, 0, 0); __builtin_amdgcn_s_setprio(0); } while (0)
#define PG8_WAIT_V(n) asm volatile("s_waitcnt vmcnt(" #n ")" ::: "memory")
#define PG8_WAIT_L(n) asm volatile("s_waitcnt lgkmcnt(" #n ")" ::: "memory")
#define PG8_BAR __builtin_amdgcn_s_barrier()
#define PG8_SCHED __builtin_amdgcn_sched_barrier(0)
    Unit cur, nxt; int ui = 0;
    if (!S.next(0, cur)) return;
    f32x4 acc[2][2][4][2];
#pragma unroll
    for (int a = 0; a < 2; ++a)
#pragma unroll
        for (int b = 0; b < 2; ++b)
#pragma unroll
            for (int m = 0; m < 4; ++m)
#pragma unroll
                for (int n = 0; n < 2; ++n) acc[a][b][m][n] = (f32x4){0.f, 0.f, 0.f, 0.f};
    bf16x8 At[4][2], B0[2][2], B1[2][2];
    const char* cA = (const char*)g.A + (size_t)cur.pm * tstep; const char* cB = (const char*)g.Bt + (size_t)cur.pn * tstep;
    if constexpr (SP2) {
        PG8_STAGE(PG8_SB(0, 0), cB, voffB); PG8_STAGE(PG8_SB(0, 1), cB + hstep, voffB); PG8_STAGE(PG8_SA(0, 0), cA, voffA); PG8_STAGE(PG8_SA(0, 1), cA + hstep, voffA);
        if (wr == 1) PG8_BAR;
        PG8_WAIT_V(2); PG8_BAR;
        PG8_STAGE(PG8_SB(1, 0), cB + kstep, voffB); PG8_STAGE(PG8_SA(1, 0), cA + kstep, voffA); PG8_STAGE(PG8_SB(1, 1), cB + hstep + kstep, voffB);
        PG8_WAIT_V(6); PG8_BAR;
    } else {
        PG8_STAGE(PG8_SB(0, 0), cB, voffB); PG8_STAGE(PG8_SA(0, 0), cA, voffA); PG8_STAGE(PG8_SB(0, 1), cB + hstep, voffB); PG8_STAGE(PG8_SA(0, 1), cA + hstep, voffA);
        if (wr == 1) PG8_BAR;
        PG8_WAIT_V(4); PG8_BAR;
        PG8_STAGE(PG8_SB(1, 0), cB + kstep, voffB); PG8_STAGE(PG8_SA(1, 0), cA + kstep, voffA); PG8_STAGE(PG8_SB(1, 1), cB + hstep + kstep, voffB);
        PG8_WAIT_V(6); PG8_BAR;
    }
    for (;;) {
        const bool has_next = S.next(ui + 1, nxt);
        const char* nA = has_next ? (const char*)g.A + (size_t)nxt.pm * tstep : cA; const char* nB = has_next ? (const char*)g.Bt + (size_t)nxt.pn * tstep : cB;
        for (int t = 0; t < nt; t += 2) {
            const bool last = (t == nt - 2);
            const char* a1 = cA + (size_t)(t + 1) * kstep;
            const char* a2 = last ? nA : cA + (size_t)(t + 2) * kstep; const char* b2 = last ? nB : cB + (size_t)(t + 2) * kstep;
            const char* a3 = a2 + kstep; const char* b3 = b2 + kstep;
            if constexpr (SP2) {
            PG8_LDB(B0, 0, 0); PG8_LDB(B1, 0, 1); PG8_SCHED; PG8_LDA(At, 0, 0); PG8_STAGE(PG8_SA(1, 1), a1 + hstep, voffA);
            PG8_WAIT_V(8); PG8_WAIT_L(0); PG8_BAR; PG8_MMA(0, 0, At, B0); PG8_MMA(0, 1, At, B1); PG8_BAR; PG8_SCHED;
            PG8_LDA(At, 0, 1); PG8_STAGE(PG8_SB(0, 0), b2, voffB); PG8_STAGE(PG8_SB(0, 1), b2 + hstep, voffB); PG8_STAGE(PG8_SA(0, 0), a2, voffA);
            PG8_WAIT_V(8); PG8_WAIT_L(0); PG8_BAR; PG8_MMA(1, 0, At, B0); PG8_MMA(1, 1, At, B1); PG8_BAR; PG8_SCHED;
            PG8_LDB(B0, 1, 0); PG8_LDB(B1, 1, 1); PG8_SCHED; PG8_LDA(At, 1, 0); PG8_STAGE(PG8_SA(0, 1), a2 + hstep, voffA);
            PG8_WAIT_V(8); PG8_WAIT_L(0); PG8_BAR; PG8_MMA(0, 0, At, B0); PG8_MMA(0, 1, At, B1); PG8_BAR; PG8_SCHED;
            PG8_LDA(At, 1, 1); PG8_STAGE(PG8_SB(1, 0), b3, voffB); PG8_STAGE(PG8_SB(1, 1), b3 + hstep, voffB); PG8_STAGE(PG8_SA(1, 0), a3, voffA);
            PG8_WAIT_V(8); PG8_WAIT_L(0); PG8_BAR; PG8_MMA(1, 0, At, B0); PG8_MMA(1, 1, At, B1); PG8_BAR; PG8_SCHED;
            } else {
            PG8_LDB(B0, 0, 0); PG8_SCHED; PG8_LDA(At, 0, 0); PG8_STAGE(PG8_SA(1, 1), a1 + hstep, voffA);
            PG8_WAIT_L(8); PG8_BAR; PG8_WAIT_L(0); PG8_MMA(0, 0, At, B0); PG8_BAR; PG8_SCHED;
            PG8_LDB(B1, 0, 1); PG8_STAGE(PG8_SB(0, 0), b2, voffB);
            PG8_BAR; PG8_WAIT_L(0); PG8_MMA(0, 1, At, B1); PG8_BAR;
            PG8_LDA(At, 0, 1); PG8_STAGE(PG8_SA(0, 0), a2, voffA);
            PG8_BAR; PG8_WAIT_L(0); PG8_MMA(1, 0, At, B0); PG8_BAR; PG8_SCHED;
            PG8_STAGE(PG8_SB(0, 1), b2 + hstep, voffB);
            PG8_WAIT_V(6); PG8_BAR; PG8_MMA(1, 1, At, B1); PG8_BAR;
            PG8_LDB(B0, 1, 0); PG8_SCHED; PG8_LDA(At, 1, 0); PG8_STAGE(PG8_SA(0, 1), a2 + hstep, voffA);
            PG8_WAIT_L(8); PG8_BAR; PG8_WAIT_L(0); PG8_MMA(0, 0, At, B0); PG8_BAR; PG8_SCHED;
            PG8_LDB(B1, 1, 1); PG8_STAGE(PG8_SB(1, 0), b3, voffB);
            PG8_BAR; PG8_WAIT_L(0); PG8_MMA(0, 1, At, B1); PG8_BAR;
            PG8_LDA(At, 1, 1); PG8_STAGE(PG8_SA(1, 0), a3, voffA);
            PG8_BAR; PG8_WAIT_L(0); PG8_MMA(1, 0, At, B0); PG8_BAR; PG8_SCHED;
            PG8_STAGE(PG8_SB(1, 1), b3 + hstep, voffB);
            PG8_WAIT_V(6); PG8_BAR; PG8_MMA(1, 1, At, B1); PG8_BAR;
            }
        }
        if constexpr (ALIGN_EPI) { if (wr == 0) PG8_BAR; }
        E(acc, cur, wr, wc, fr, fq);
        if (!has_next) break;
#pragma unroll
        for (int a = 0; a < 2; ++a)
#pragma unroll
            for (int b = 0; b < 2; ++b)
#pragma unroll
                for (int m = 0; m < 4; ++m)
#pragma unroll
                    for (int n = 0; n < 2; ++n) acc[a][b][m][n] = (f32x4){0.f, 0.f, 0.f, 0.f};
        cur = nxt; cA = nA; cB = nB; ++ui;
        if constexpr (ALIGN_EPI) { if (wr == 1) PG8_BAR; }
    }
    PG8_WAIT_V(0);
    if constexpr (!ALIGN_EPI) { if (wr == 0) PG8_BAR; }
    PG8_BAR;
#undef PG8_SA
#undef PG8_SB
#undef PG8_STAGE
#undef PG8_LDA
#undef PG8_LDB
#undef PG8_MMA
#undef PG8_WAIT_V
#undef PG8_WAIT_L
#undef PG8_BAR
#undef PG8_SCHED
}

DI float act_relu2(float v) { const float r = v > 0.f ? v : 0.f; return r * r; }
DI float act_gelu_tanh(float v) { const float u = 0.7978845608028654f * (v + 0.044715f * v * v * v); return v * __builtin_amdgcn_rcpf(1.0f + __builtin_amdgcn_exp2f(u * -2.8853900817779268f)); }

template <int ACT, bool CMP, bool HAS_IN = false, bool HAS_OUT = false> struct EpiBf16 {
    static constexpr bool PERM = true;
    bf16_t* O; int ldc; const float* ssq_in; float* ssq_out;
    DI void operator()(const f32x4 (&acc)[2][2][4][2], const Unit& u, int wr, int wc, int fr, int fq) const {
        const int row0 = u.pm * BM + wr * 64 + fr; const int col0 = (CMP ? 0 : u.pn * BM) + wc * 32 + 8 * fq;
        float rs8[2][4];
        if (HAS_IN) {
#pragma unroll
            for (int ai = 0; ai < 2; ++ai)
#pragma unroll
                for (int m = 0; m < 4; ++m) rs8[ai][m] = ssq_in[row0 + ai * HALF + m * 16];
#pragma unroll
            for (int ai = 0; ai < 2; ++ai)
#pragma unroll
                for (int m = 0; m < 4; ++m) rs8[ai][m] = rsqrtf(rs8[ai][m] * (1.f / DM) + NORM_EPS);
            __builtin_amdgcn_sched_barrier(0);
        }
#pragma unroll
        for (int ai = 0; ai < 2; ++ai)
#pragma unroll
            for (int m = 0; m < 4; ++m) { const int r = row0 + ai * HALF + m * 16; bf16_t* rowp = O + (size_t)r * ldc + col0;
                float rsc = 1.f; if (HAS_IN) rsc = rs8[ai][m];
                float sq = 0.f;
#pragma unroll
                for (int bj = 0; bj < 2; ++bj) { f32x4 v0 = acc[ai][bj][m][0], v1 = acc[ai][bj][m][1];
                    if (HAS_IN) { v0 = v0 * rsc; v1 = v1 * rsc; }
                    if (ACT == 1) { for (int j = 0; j < 4; ++j) { v0[j] = act_relu2(v0[j]); v1[j] = act_relu2(v1[j]); } }
                    if (ACT == 2) { for (int j = 0; j < 4; ++j) { v0[j] = act_gelu_tanh(v0[j]); v1[j] = act_gelu_tanh(v1[j]); } }
                    if (HAS_OUT) sq += (v0[0] * v0[0] + v0[1] * v0[1]) + (v0[2] * v0[2] + v0[3] * v0[3]) + (v1[0] * v1[0] + v1[1] * v1[1]) + (v1[2] * v1[2] + v1[3] * v1[3]);
                    u32x4 w; w.x = pk2(v0[0], v0[1]); w.y = pk2(v0[2], v0[3]); w.z = pk2(v1[0], v1[1]); w.w = pk2(v1[2], v1[3]);
                    *(u32x4*)(rowp + bj * HALF) = w; }
                if (HAS_OUT) { sq += __shfl_xor(sq, 16); sq += __shfl_xor(sq, 32); if (fq == 0) atomicAdd(ssq_out + r, sq); } }
    }
};
template <bool ADD> struct EpiGate {
    static constexpr bool PERM = true;
    bf16_t* O; int ldc; const bf16_t* Gt; int ldg;
    DI void operator()(const f32x4 (&acc)[2][2][4][2], const Unit& u, int wr, int wc, int fr, int fq) const {
        const int row0 = u.pm * BM + wr * 64 + fr; const int col0 = u.pn * BM + wc * 32 + 8 * fq;
        u32x4 gw[2][2][2], pw[2][2][2];
#define EG_LOAD(q, S) do { _Pragma("unroll") for (int mm = 0; mm < 2; ++mm) _Pragma("unroll") for (int bj = 0; bj < 2; ++bj) { \
            const size_t r_ = (size_t)(row0 + ((q) >> 1) * HALF + (2 * ((q) & 1) + mm) * 16); \
            gw[S][mm][bj] = *(const u32x4*)(Gt + r_ * ldg + col0 + bj * HALF); \
            if (ADD) pw[S][mm][bj] = *(const u32x4*)(O + r_ * ldc + col0 + bj * HALF); } } while (0)
        EG_LOAD(0, 0);
#pragma unroll
        for (int q = 0; q < 4; ++q) {
            if (q + 1 < 4) { if (q & 1) EG_LOAD(q + 1, 0); else EG_LOAD(q + 1, 1); }
            __builtin_amdgcn_sched_barrier(0);
            const int ai = q >> 1, mh = q & 1;
#pragma unroll
            for (int mm = 0; mm < 2; ++mm) { const int m = 2 * mh + mm; const size_t r = (size_t)(row0 + ai * HALF + m * 16);
#pragma unroll
                for (int bj = 0; bj < 2; ++bj) { const f32x4 v0 = acc[ai][bj][m][0], v1 = acc[ai][bj][m][1]; const u32x4 g = gw[q & 1][mm][bj];
                    float o[8];
                    o[0] = sigmoidf_(bflo(g.x)) * v0[0]; o[1] = sigmoidf_(bfhi(g.x)) * v0[1]; o[2] = sigmoidf_(bflo(g.y)) * v0[2]; o[3] = sigmoidf_(bfhi(g.y)) * v0[3];
                    o[4] = sigmoidf_(bflo(g.z)) * v1[0]; o[5] = sigmoidf_(bfhi(g.z)) * v1[1]; o[6] = sigmoidf_(bflo(g.w)) * v1[2]; o[7] = sigmoidf_(bfhi(g.w)) * v1[3];
                    if (ADD) { const u32x4 p = pw[q & 1][mm][bj];
                        o[0] += bflo(p.x); o[1] += bfhi(p.x); o[2] += bflo(p.y); o[3] += bfhi(p.y); o[4] += bflo(p.z); o[5] += bfhi(p.z); o[6] += bflo(p.w); o[7] += bfhi(p.w); }
                    u32x4 w; w.x = pk2(o[0], o[1]); w.y = pk2(o[2], o[3]); w.z = pk2(o[4], o[5]); w.w = pk2(o[6], o[7]);
                    *(u32x4*)(O + r * ldc + col0 + bj * HALF) = w; } }
            __builtin_amdgcn_sched_barrier(0);
        }
#undef EG_LOAD
    }
};
struct EpiRes {
    static constexpr bool PERM = false;
    const float* base; float* out; int ldc; bf16_t* xb; float* ssq;
    DI void operator()(const f32x4 (&acc)[2][2][4][2], const Unit& u, int wr, int wc, int fr, int fq) const {
        const int row0 = u.pm * BM + wr * 64 + fr; const int col0 = u.pn * BM + wc * 32 + 4 * fq;
        f32x4 bs[2][2][2][2];
#define ER_LOAD(q, S) do { _Pragma("unroll") for (int mm = 0; mm < 2; ++mm) _Pragma("unroll") for (int bj = 0; bj < 2; ++bj) _Pragma("unroll") for (int n = 0; n < 2; ++n) \
            bs[S][mm][bj][n] = *(const f32x4*)(base + (size_t)(row0 + ((q) >> 1) * HALF + (2 * ((q) & 1) + mm) * 16) * ldc + col0 + bj * HALF + n * 16); } while (0)
        ER_LOAD(0, 0);
#pragma unroll
        for (int q = 0; q < 4; ++q) {
            if (q + 1 < 4) { if (q & 1) ER_LOAD(q + 1, 0); else ER_LOAD(q + 1, 1); }
            __builtin_amdgcn_sched_barrier(0);
            const int ai = q >> 1, mh = q & 1;
#pragma unroll
            for (int mm = 0; mm < 2; ++mm) { const int m = 2 * mh + mm; const int r = row0 + ai * HALF + m * 16; const size_t off = (size_t)r * ldc + col0; float sq = 0.f;
#pragma unroll
                for (int bj = 0; bj < 2; ++bj)
#pragma unroll
                    for (int n = 0; n < 2; ++n) { const int cc = bj * HALF + n * 16; const f32x4 o = bs[q & 1][mm][bj][n] + acc[ai][bj][m][n];
                        *(f32x4*)(out + off + cc) = o; sq += (o[0] * o[0] + o[1] * o[1]) + (o[2] * o[2] + o[3] * o[3]);
                        u32x2 w; w.x = pk2(o[0], o[1]); w.y = pk2(o[2], o[3]); *(u32x2*)(xb + off + cc) = w; }
                sq += __shfl_xor(sq, 16); sq += __shfl_xor(sq, 32); if (fq == 0) atomicAdd(ssq + r, sq); }
            __builtin_amdgcn_sched_barrier(0);
        }
#undef ER_LOAD
    }
};
struct EpiFinal {
    static constexpr bool PERM = false;
    const float* base; float* out; int ldc; const bf16_t* pe; const float* ssq2; const float* ssqpe; const float* gn;
    DI void operator()(const f32x4 (&acc)[2][2][4][2], const Unit& u, int wr, int wc, int fr, int fq) const {
        const int row0 = u.pm * BM + wr * 64 + fr; const int col0 = u.pn * BM + wc * 32 + 4 * fq;
        float s2a[2][4], spa[2][4];
#pragma unroll
        for (int ai = 0; ai < 2; ++ai)
#pragma unroll
            for (int m = 0; m < 4; ++m) { const int r = row0 + ai * HALF + m * 16; s2a[ai][m] = ssq2[r]; spa[ai][m] = ssqpe[r]; }
#pragma unroll
        for (int ai = 0; ai < 2; ++ai)
#pragma unroll
        for (int mh = 0; mh < 2; ++mh) {
            f32x4 bs[2][2][2]; u32x2 pw[2][2][2]; float s2[2], sp[2];
#pragma unroll
            for (int mm = 0; mm < 2; ++mm) { const int r = row0 + ai * HALF + (2 * mh + mm) * 16; s2[mm] = s2a[ai][2 * mh + mm]; sp[mm] = spa[ai][2 * mh + mm];
#pragma unroll
                for (int bj = 0; bj < 2; ++bj)
#pragma unroll
                    for (int n = 0; n < 2; ++n) { const size_t o_ = (size_t)r * ldc + col0 + bj * HALF + n * 16; bs[mm][bj][n] = *(const f32x4*)(base + o_); pw[mm][bj][n] = *(const u32x2*)(pe + o_); } }
            __builtin_amdgcn_sched_barrier(0);
#pragma unroll
            for (int mm = 0; mm < 2; ++mm) { const int m = 2 * mh + mm; const int r = row0 + ai * HALF + m * 16; const size_t off = (size_t)r * ldc + col0;
                const float rs2 = rsqrtf(s2[mm] * (1.f / DM) + NORM_EPS), rsr = rsqrtf(sp[mm] * (1.f / DM) + NORM_EPS);
#pragma unroll
                for (int bj = 0; bj < 2; ++bj)
#pragma unroll
                    for (int n = 0; n < 2; ++n) { const int cc = bj * HALF + n * 16; const f32x4 b4 = bs[mm][bj][n], gg = *(const f32x4*)(gn + col0 + cc); const u32x2 p = pw[mm][bj][n]; const f32x4 a = acc[ai][bj][m][n] * rs2; f32x4 o;
                        o[0] = b4[0] + sigmoidf_(a[0]) * (bflo(p.x) * rsr * gg[0]); o[1] = b4[1] + sigmoidf_(a[1]) * (bfhi(p.x) * rsr * gg[1]);
                        o[2] = b4[2] + sigmoidf_(a[2]) * (bflo(p.y) * rsr * gg[2]); o[3] = b4[3] + sigmoidf_(a[3]) * (bfhi(p.y) * rsr * gg[3]);
                        *(f32x4*)(out + off + cc) = o; } }
        }
    }
};
}

struct Params { const float* in[23]; float* out; unsigned char* ws; };

struct Frame {
    LAS unsigned char* lds;
    int tid, lane, wave, G, bid, vcu;
    const float *x, *p; const int* pos;
    const float *norm_mix, *w_in, *dqn, *dkn, *dlam, *subln, *nqn, *nkn, *cpos, *cw1, *cw2, *wpd, *wpn, *wout, *norm_mlp, *wup, *wdn, *wple, *norm_ple, *wgate;
    float* out;
    bf16_t *WIN, *WUP, *WDN, *WOUT, *WGATE, *WPD, *WPN, *WPLE, *WC1, *H, *Z, *PE, *PB, *X1B, *HIDN;
    float *SSQ1, *SSQ2, *SSQPE;
    bf16_t *YA, *YB, *BLK, *HID, *KC, *VC, *QP, *KD, *VD, *NKV;
    float* ROPE;
};

DI void transpose_item(const float* W, int K, int N, int Npad, bf16_t* WT, LAS float* scr, int item, int lane, const float* kscale = nullptr) {
    const int nblk = Npad / 32, kb = item / nblk, nb = item % nblk, k0 = 64 * kb, n0 = 32 * nb;
    const int nn = n0 + (lane & 31);
    float tv[32];
#pragma unroll
    for (int i = 0; i < 32; ++i) { const int kk = 2 * i + (lane >> 5); tv[i] = (nn < N) ? W[(size_t)(k0 + kk) * N + nn] : 0.f; }
    if (kscale) {
#pragma unroll
        for (int i = 0; i < 32; ++i) tv[i] *= kscale[k0 + 2 * i + (lane >> 5)];
    }
#pragma unroll
    for (int i = 0; i < 32; ++i) { const int kk = 2 * i + (lane >> 5); scr[kk * 33 + (lane & 31)] = tv[i]; }
    LDS_WAIT(); asm volatile("" ::: "memory");
    const int c = lane & 7;
#pragma unroll
    for (int j = 0; j < 4; ++j) { const int n = (lane >> 3) + 8 * j; const LAS float* s = scr + (8 * c) * 33 + n;
        u32x4 o; o.x = pk2(s[0 * 33], s[1 * 33]); o.y = pk2(s[2 * 33], s[3 * 33]); o.z = pk2(s[4 * 33], s[5 * 33]); o.w = pk2(s[6 * 33], s[7 * 33]);
        *(u32x4*)(WT + (size_t)(n0 + n) * K + k0 + 8 * c) = o; }
    LDS_WAIT(); asm volatile("" ::: "memory");
}
DI void rms_row_bf16(const float* xrow, const float* gain, bf16_t* orow, int lane) {
    const f32x4* xr = (const f32x4*)xrow + lane;
    f32x4 v[8]; float s = 0.f;
#pragma unroll
    for (int j = 0; j < 8; ++j) { v[j] = xr[64 * j]; s += (v[j].x * v[j].x + v[j].y * v[j].y) + (v[j].z * v[j].z + v[j].w * v[j].w); }
    const float rs = rsqrtf(wave_sum(s) * (1.f / DM) + NORM_EPS);
    u32x2* o8 = (u32x2*)orow + lane;
#pragma unroll
    for (int j = 0; j < 8; ++j) { f32x4 g = {1.f, 1.f, 1.f, 1.f}; if (gain) g = *((const f32x4*)gain + lane + 64 * j);
        u32x2 w; w.x = pk2(v[j].x * rs * g.x, v[j].y * rs * g.y); w.y = pk2(v[j].z * rs * g.z, v[j].w * rs * g.w); o8[64 * j] = w; }
}
DI void p0_prologue(Frame& F) {
    LAS float* scr = (LAS float*)(F.lds + F.wave * 16384);
    const int gw = F.vcu * NWAVES + F.wave, NGW = F.G * NWAVES;
    constexpr int I_IN = 32 * 288, I_UP = 32 * 256, I_DN = 128 * 64, I_SQ = 32 * 64, I_PJ = 16 * 64, I_PLE = 4 * 64, I_C1 = 32 * 8;
    constexpr int NITEMS = I_IN + I_UP + I_DN + 2 * I_SQ + 2 * I_PJ + I_PLE + 2 * I_C1;
    for (int it = gw; it < NITEMS; it += NGW) {
        int r = it;
        if (r < I_IN) { transpose_item(F.w_in, DM, INW, LDZ, F.WIN, scr, r, F.lane); continue; } r -= I_IN;
        if (r < I_UP) { transpose_item(F.wup, DM, DFF, DFF, F.WUP, scr, r, F.lane, F.norm_mlp); continue; } r -= I_UP;
        if (r < I_DN) { transpose_item(F.wdn, DFF, DM, DM, F.WDN, scr, r, F.lane); continue; } r -= I_DN;
        if (r < I_SQ) { transpose_item(F.wout, DM, DM, DM, F.WOUT, scr, r, F.lane); continue; } r -= I_SQ;
        if (r < I_SQ) { transpose_item(F.wgate, DM, DM, DM, F.WGATE, scr, r, F.lane); continue; } r -= I_SQ;
        if (r < I_PJ) { transpose_item(F.wpd, 1024, DM, DM, F.WPD, scr, r, F.lane); continue; } r -= I_PJ;
        if (r < I_PJ) { transpose_item(F.wpn, 1024, DM, DM, F.WPN, scr, r, F.lane); continue; } r -= I_PJ;
        if (r < I_PLE) { transpose_item(F.wple, PLE, DM, DM, F.WPLE, scr, r, F.lane); continue; } r -= I_PLE;
        if (r < I_C1) { transpose_item(F.cw1, 2048, 256, 256, F.WC1, scr, r, F.lane); continue; } r -= I_C1;
        transpose_item(F.cw1 + (size_t)2048 * 256, 2048, 256, 256, F.WC1 + (size_t)256 * 2048, scr, r, F.lane);
    }
    for (int m = gw; m < T; m += NGW) rms_row_bf16(F.x + (size_t)m * DM, F.norm_mix, F.H + (size_t)m * DM, F.lane);
    for (int e = gw * 64 + F.lane; e < T * 8; e += NGW * 64) {
        const int tok = e >> 3, j = e & 7;
        const float invf = j == 0 ? 1.0f : j == 1 ? 0.1939227432012558f : j == 2 ? 0.03760603070259094f : j == 3 ? 0.007292664609849453f :
                           j == 4 ? 0.0014142135623842478f : j == 5 ? 0.00027424818836152554f : j == 6 ? 5.318296098266728e-05f : 1.0313386155758053e-05f;
        const float ang = (float)F.pos[tok] * invf;
        double t = (double)ang * 0.15915494309189535; t -= rint(t);
        const float fr = (float)t;
        F.ROPE[tok * 16 + j] = __builtin_amdgcn_cosf(fr); F.ROPE[tok * 16 + 8 + j] = __builtin_amdgcn_sinf(fr);
    }
}

DI void head_norm_rope(const bf16_t* ptr, bf16_t* dst, const float* gain8, int sub, const float* cs, const float* sn, bf16_t* plain, bool active, float oscale = 1.0f) {
    u32x4 w = {0u, 0u, 0u, 0u};
    if (active) w = *(const u32x4*)ptr;
    float v[8] = {bflo(w.x), bfhi(w.x), bflo(w.y), bfhi(w.y), bflo(w.z), bfhi(w.z), bflo(w.w), bfhi(w.w)};
    float ss = 0.f;
#pragma unroll
    for (int j = 0; j < 8; ++j) ss += v[j] * v[j];
    ss += __shfl_xor(ss, 1); ss += __shfl_xor(ss, 2); ss += __shfl_xor(ss, 4);
    const float rs = rsqrtf(ss * (1.f / 64.f) + NORM_EPS);
    const f32x4 g0 = *(const f32x4*)gain8, g1 = *(const f32x4*)(gain8 + 4);
    float y[8];
#pragma unroll
    for (int j = 0; j < 8; ++j) y[j] = v[j] * (rs * oscale) * (j < 4 ? g0[j] : g1[j - 4]);
    if (plain && active && sub < 2) { u32x4 o; o.x = pk2(y[0], y[1]); o.y = pk2(y[2], y[3]); o.z = pk2(y[4], y[5]); o.w = pk2(y[6], y[7]); *(u32x4*)plain = o; }
    float yp[8];
#pragma unroll
    for (int j = 0; j < 8; ++j) yp[j] = __shfl_xor(y[j], 1);
    if (sub == 0) {
#pragma unroll
        for (int j = 0; j < 8; ++j) y[j] = y[j] * cs[j] - yp[j] * sn[j];
    } else if (sub == 1) {
#pragma unroll
        for (int j = 0; j < 8; ++j) y[j] = y[j] * cs[j] + yp[j] * sn[j];
    }
    if (active) { u32x4 o; o.x = pk2(y[0], y[1]); o.y = pk2(y[2], y[3]); o.z = pk2(y[4], y[5]); o.w = pk2(y[6], y[7]); *(u32x4*)dst = o; }
}
DI void p2a_blocks(Frame& F) {
    const int gw = F.vcu * NWAVES + F.wave, NGW = F.G * NWAVES, lane = F.lane, sub = lane & 7, d0 = sub * 8;
    for (int e = gw * 64 + lane; e < 3 * T; e += NGW * 64) F.SSQ1[e] = 0.f;
    for (int tok = gw; tok < T; tok += NGW) {
        bf16_t* zr = F.Z + (size_t)tok * LDZ;
        if (lane < 32) {
            const int kv = lane >> 4, g = (lane >> 3) & 1;
            const u32x4 w = *(const u32x4*)(zr + (kv ? ZC_VC : ZC_KC) + g * 64 + d0);
            const float v[8] = {bflo(w.x), bfhi(w.x), bflo(w.y), bfhi(w.y), bflo(w.z), bfhi(w.z), bflo(w.w), bfhi(w.w)};
            const int b = tok / SEQ, s = tok % SEQ;
#pragma unroll
            for (int which = 0; which < 2; ++which) {
                const int n = (s >> 4) - which;
                if (n >= 0 && n <= 254) {
                    const int l = s - 16 * n;
                    const float* pp = F.cpos + ((size_t)kv * 32 + l) * 64 + d0;
                    const f32x4 p0 = *(const f32x4*)pp, p1 = *(const f32x4*)(pp + 4);
                    u32x4 o; o.x = pk2(v[0] + p0[0], v[1] + p0[1]); o.y = pk2(v[2] + p0[2], v[3] + p0[3]); o.z = pk2(v[4] + p1[0], v[5] + p1[1]); o.w = pk2(v[6] + p1[2], v[7] + p1[3]);
                    *(u32x4*)(F.BLK + ((size_t)kv * 2048 + (size_t)(b * 2 + g) * 256 + n) * 2048 + l * 64 + d0) = o;
                }
            }
        }
    }
}
DI void p2_postprocess(Frame& F, int gw, int NGW) {
    const int lane = F.lane, sub = lane & 7, d0 = sub * 8;
    for (int tok = gw; tok < T; tok += NGW) {
        bf16_t* zr = F.Z + (size_t)tok * LDZ;
        float cs[8], sn[8];
#pragma unroll
        for (int j = 0; j < 8; ++j) { cs[j] = F.ROPE[tok * 16 + j]; sn[j] = F.ROPE[tok * 16 + 8 + j]; }
        const int b = tok / SEQ, sq = tok % SEQ;
#pragma unroll
        for (int ch = 0; ch < 2; ++ch) {
            head_norm_rope(zr + ZC_DQ + ch * 512 + lane * 8, zr + ZC_DQ + ch * 512 + lane * 8, F.dqn + d0, sub, cs, sn, nullptr, true, SC_L2E);
            head_norm_rope(zr + ZC_DK + ch * 512 + lane * 8, F.KD + ((size_t)(b * 16 + ch * 8 + (lane >> 3)) * SEQ + sq) * 64 + d0, F.dkn + d0, sub, cs, sn, nullptr, true);
            head_norm_rope(zr + ZC_NQ + ch * 512 + lane * 8, zr + ZC_NQ + ch * 512 + lane * 8, F.nqn + d0, sub, cs, sn, F.QP + ((size_t)tok * 16 + ch * 8 + (lane >> 3)) * 16 + sub * 8, true, SC_L2E);
        }
        {
          const int kind = lane < 16 ? 0 : 2, g = (lane >> 3) & 1;
          head_norm_rope(zr + (lane < 16 ? ZC_KS + lane * 8 : ZC_KW + (lane - 16) * 8), F.NKV + ((size_t)(kind * 8 + b * 2 + g) * SEQ + sq) * 64 + d0, F.nkn + d0, sub, cs, sn, nullptr, lane < 32);
          if (lane >= 32) { const int l2 = lane - 32, kind2 = l2 < 16 ? 1 : 3;
              const u32x4 w = *(const u32x4*)(zr + (l2 < 16 ? ZC_VS + l2 * 8 : ZC_VW + (l2 - 16) * 8));
              *(u32x4*)(F.NKV + ((size_t)(kind2 * 8 + b * 2 + g) * SEQ + sq) * 64 + d0) = w; } }
        {
          const int col = lane * 16, hh = col >> 7, dvi = col & 127;
          const u32x4 w0 = *(const u32x4*)(zr + ZC_DV + col), w1 = *(const u32x4*)(zr + ZC_DV + col + 8);
          bf16_t* dp = F.VD + ((size_t)(b * 8 + hh) * SEQ + sq) * 128 + dvi;
          *(u32x4*)dp = w0; *(u32x4*)(dp + 8) = w1; }
    }
}

constexpr int KP = 144;
typedef short v4i16_t __attribute__((ext_vector_type(4)));
DI s16x4 vtr(const LAS unsigned char* p) { return __builtin_bit_cast(s16x4, __builtin_amdgcn_ds_read_tr16_b64_v4i16((LAS v4i16_t*)p)); }
DI void qk_tile(f32x16& s0, f32x16& s1, const LAS unsigned char* kt, const bf16x8* qf, int r32, int hi, float soff) {
    const LAS unsigned char* kp = kt + r32 * KP + hi * 16;
    f32x16 z; for (int i = 0; i < 16; ++i) z[i] = soff;
    s0 = z; s1 = z;
#pragma unroll
    for (int c = 0; c < 4; ++c) {
        const bf16x8 a0 = *(const LAS bf16x8*)(kp + c * 32);
        const bf16x8 a1 = *(const LAS bf16x8*)(kp + 32 * KP + c * 32);
        s0 = MFMA32(a0, qf[c], s0); s1 = MFMA32(a1, qf[c], s1);
    }
}
DI bf16x8 pack8(const f32x16& p, int b) {
    u32x4 w; w.x = pk2(p[b], p[b + 1]); w.y = pk2(p[b + 2], p[b + 3]); w.z = pk2(p[b + 4], p[b + 5]); w.w = pk2(p[b + 6], p[b + 7]);
    return __builtin_bit_cast(bf16x8, w);
}
template <int NDT, int VP> DI void pv_tile(f32x16* o, const LAS unsigned char* vt, const f32x16& p0, const f32x16& p1, int lane) {
    const int hi = lane >> 5, i16 = lane & 15, q = i16 >> 2, p = i16 & 3, blk = (lane >> 4) & 1;
    const LAS unsigned char* vb = vt + (4 * hi + q) * VP + (16 * blk + 4 * p) * 2;
    bf16x8 pf[4]; pf[0] = pack8(p0, 0); pf[1] = pack8(p0, 8); pf[2] = pack8(p1, 0); pf[3] = pack8(p1, 8);
    s16x4 lo[2][4], hh[2][4];
#pragma unroll
    for (int f = 0; f < 4; ++f) { lo[0][f] = vtr(vb + (16 * f) * VP); hh[0][f] = vtr(vb + (16 * f + 8) * VP); }
#pragma unroll
    for (int dt = 0; dt < NDT; ++dt) {
        if (dt + 1 < NDT) {
#pragma unroll
            for (int f = 0; f < 4; ++f) { lo[(dt + 1) & 1][f] = vtr(vb + (16 * f) * VP + (dt + 1) * 64); hh[(dt + 1) & 1][f] = vtr(vb + (16 * f + 8) * VP + (dt + 1) * 64); }
        }
        __builtin_amdgcn_sched_barrier(0);
#pragma unroll
        for (int f = 0; f < 4; ++f) {
            const s16x4 l4 = lo[dt & 1][f], h4 = hh[dt & 1][f];
            const bf16x8 vf = {l4[0], l4[1], l4[2], l4[3], h4[0], h4[1], h4[2], h4[3]};
            o[dt] = MFMA32(vf, pf[f], o[dt]);
        }
        __builtin_amdgcn_sched_barrier(0);
    }
}
constexpr float LAZY_THR = 8.0f;
DI float xhalf_max(float v) { const unsigned u = __float_as_uint(v); auto rr = __builtin_amdgcn_permlane32_swap(u, u, false, false); return fmaxf(__uint_as_float(rr[0]), __uint_as_float(rr[1])); }
DI float xhalf_sum(float v) { const unsigned u = __float_as_uint(v); auto rr = __builtin_amdgcn_permlane32_swap(u, u, false, false); return __uint_as_float(rr[0]) + __uint_as_float(rr[1]); }
DI float tile_max(const f32x16& s0, const f32x16& s1) {
    float a = fmaxf(fmaxf(s0[0], s0[1]), s1[0]), b = fmaxf(fmaxf(s0[2], s0[3]), s1[1]); a = fmaxf(fmaxf(a, s1[2]), s1[3]);
#pragma unroll
    for (int r = 4; r < 16; r += 4) { a = fmaxf(fmaxf(a, s0[r]), s0[r + 1]); b = fmaxf(fmaxf(b, s0[r + 2]), s0[r + 3]); a = fmaxf(fmaxf(a, s1[r]), s1[r + 1]); b = fmaxf(fmaxf(b, s1[r + 2]), s1[r + 3]); }
    return fmaxf(a, b);
}
template <int NDT> DI void online_step(f32x16& s0, f32x16& s1, float& m, float& l, f32x16* o, bool lane_on) {
    (void)m; (void)o;
    const float off = lane_on ? 0.f : -INFINITY;
    float sum0 = 0.f, sum1 = 0.f;
#pragma unroll
    for (int i = 0; i < 16; ++i) { s0[i] = __builtin_amdgcn_exp2f(s0[i] + off); s1[i] = __builtin_amdgcn_exp2f(s1[i] + off); sum0 += s0[i]; sum1 += s1[i]; }
    l += sum0 + sum1;
}

template <int NDT, int VP, bool HAS_OFF> DI void softmax_pv(f32x16& s0, f32x16& s1, float& l, f32x16* o, const LAS unsigned char* vt, int lane, float off) {
    const int hi = lane >> 5, i16 = lane & 15, q = i16 >> 2, p = i16 & 3, blk = (lane >> 4) & 1;
    const LAS unsigned char* vb = vt + (4 * hi + q) * VP + (16 * blk + 4 * p) * 2;
    s16x4 lo[2][NDT], hh[2][NDT];
#pragma unroll
    for (int dt = 0; dt < NDT; ++dt) { lo[0][dt] = vtr(vb + dt * 64); hh[0][dt] = vtr(vb + 8 * VP + dt * 64); }
    float sum = 0.f;
#pragma unroll
    for (int f = 0; f < 4; ++f) {
        if (f + 1 < 4) {
#pragma unroll
            for (int dt = 0; dt < NDT; ++dt) { lo[(f + 1) & 1][dt] = vtr(vb + (16 * (f + 1)) * VP + dt * 64); hh[(f + 1) & 1][dt] = vtr(vb + (16 * (f + 1) + 8) * VP + dt * 64); }
        }
        f32x16& sv = (f < 2) ? s0 : s1;
        const int b = 8 * (f & 1);
        float e[8];
#pragma unroll
        for (int j = 0; j < 8; ++j) { e[j] = __builtin_amdgcn_exp2f(HAS_OFF ? sv[b + j] + off : sv[b + j]); sum += e[j]; }
        u32x4 w; w.x = pk2(e[0], e[1]); w.y = pk2(e[2], e[3]); w.z = pk2(e[4], e[5]); w.w = pk2(e[6], e[7]);
        const bf16x8 pf = __builtin_bit_cast(bf16x8, w);
        __builtin_amdgcn_sched_barrier(0);
#pragma unroll
        for (int dt = 0; dt < NDT; ++dt) {
            const s16x4 l4 = lo[f & 1][dt], h4 = hh[f & 1][dt];
            const bf16x8 vf = {l4[0], l4[1], l4[2], l4[3], h4[0], h4[1], h4[2], h4[3]};
            o[dt] = MFMA32(vf, pf, o[dt]);
        }
        __builtin_amdgcn_sched_barrier(0);
    }
    l += sum;
}
DI u32x4 pair_swap16(u32x2 a, u32x2 b) {
    auto rx = __builtin_amdgcn_permlane32_swap(a.x, b.x, false, false);
    auto ry = __builtin_amdgcn_permlane32_swap(a.y, b.y, false, false);
    return (u32x4){rx[0], ry[0], rx[1], ry[1]};
}
constexpr int DF_K0 = 0, DF_K1 = 2 * 64 * KP, DF_V = 4 * 64 * KP, DF_VB = 64 * 320;
DI void diff_unit(Frame& F, int b, int h, int qt, float lam, float soff) {
    const int tid = F.tid, lane = F.lane, wid = F.wave, r32 = lane & 31, hi = lane >> 5, c = wid >> 2, wq = wid & 3;
    const int q0w = qt * 128 + wq * 32, qpos = q0w + r32;
    const bf16_t* zb = F.Z + (size_t)b * SEQ * LDZ;
    bf16x8 qf[4];
    { const bf16_t* qrow = zb + (size_t)qpos * LDZ + ZC_DQ + h * 128 + c * 64 + hi * 8;
#pragma unroll
      for (int cc = 0; cc < 4; ++cc) qf[cc] = *(const bf16x8*)(qrow + cc * 16); }
    f32x16 o[4];
#pragma unroll
    for (int dt = 0; dt < 4; ++dt) for (int i = 0; i < 16; ++i) o[dt][i] = 0.f;
    float m = -INFINITY, l = 0.f;
    const int NT = 2 * (qt + 1);
    const int krow = tid >> 3, kch = tid & 7, vrow = tid >> 4, vch = tid & 15;
    const bf16_t* kg = F.KD + ((size_t)(b * 16 + h * 2) * SEQ + krow) * 64 + kch * 8;
    const bf16_t* vg = F.VD + ((size_t)(b * 8 + h) * SEQ + vrow) * 128 + vch * 8;
    constexpr size_t K1O = (size_t)SEQ * 64;
    LAS unsigned char* const lk0 = F.lds + DF_K0 + krow * KP + kch * 16;
    LAS unsigned char* const lk1 = F.lds + DF_K1 + krow * KP + kch * 16;
    LAS unsigned char* const lv = F.lds + DF_V + vrow * 320 + vch * 16;
    u32x4 rk0, rk1, rv0, rv1;
    {
        rk0 = *(const u32x4*)(kg); rk1 = *(const u32x4*)(kg + K1O); rv0 = *(const u32x4*)(vg); rv1 = *(const u32x4*)(vg + 32 * 128);
        const u32x4 t1 = *(const u32x4*)(kg + K1O + 64 * 64);
        *(LAS u32x4*)lk0 = rk0; *(LAS u32x4*)lk1 = rk1; *(LAS u32x4*)(lk1 + 64 * KP) = t1; *(LAS u32x4*)lv = rv0; *(LAS u32x4*)(lv + 32 * 320) = rv1;
    }
    __syncthreads();
    f32x16 s0, s1;
    if (c == 1) qk_tile(s0, s1, F.lds + DF_K1, qf, r32, hi, soff);
    __syncthreads();
#define DF_SOFTMAX_PV(kt) do { \
        if (64 * (kt) + 63 > q0w) { \
            _Pragma("unroll") for (int i = 0; i < 16; ++i) { const int key = 64 * (kt) + crow(i, hi); \
                s0[i] = (key <= qpos) ? s0[i] : -INFINITY; s1[i] = (key + 32 <= qpos) ? s1[i] : -INFINITY; } \
        } \
        softmax_pv<4, 320, false>(s0, s1, l, o, F.lds + DF_V + ((kt) & 1) * DF_VB, lane, 0.f); } while (0)
#define DF_LOADS(kt) do { \
        if ((kt) + 1 < NT) { rk0 = *(const u32x4*)(kg + (size_t)((kt) + 1) * 4096); rv0 = *(const u32x4*)(vg + (size_t)((kt) + 1) * 8192); rv1 = *(const u32x4*)(vg + (size_t)((kt) + 1) * 8192 + 32 * 128); } \
        if ((kt) + 2 < NT) rk1 = *(const u32x4*)(kg + K1O + (size_t)((kt) + 2) * 4096); } while (0)
#define DF_STORES(kt) do { \
        if ((kt) + 1 < NT) { *(LAS u32x4*)(lk0 + (((kt) + 1) & 1) * 64 * KP) = rk0; *(LAS u32x4*)(lv + (((kt) + 1) & 1) * DF_VB) = rv0; *(LAS u32x4*)(lv + (((kt) + 1) & 1) * DF_VB + 32 * 320) = rv1; } \
        if ((kt) + 2 < NT) *(LAS u32x4*)(lk1 + ((kt) & 1) * 64 * KP) = rk1; \
        __syncthreads(); } while (0)
    if (c == 0) {
        for (int kt = 0; kt < NT; ++kt) {
            DF_LOADS(kt);
            if (64 * kt <= q0w + 31) {
                qk_tile(s0, s1, F.lds + DF_K0 + (kt & 1) * 64 * KP, qf, r32, hi, soff);
                DF_SOFTMAX_PV(kt);
            }
            DF_STORES(kt);
        }
    } else {
        for (int kt = 0; kt < NT; ++kt) {
            DF_LOADS(kt);
            if (64 * kt <= q0w + 31) DF_SOFTMAX_PV(kt);
            if ((kt + 1 < NT) && (64 * (kt + 1) <= q0w + 31)) qk_tile(s0, s1, F.lds + DF_K1 + ((kt + 1) & 1) * 64 * KP, qf, r32, hi, soff);
            DF_STORES(kt);
        }
    }
#undef DF_LOADS
#undef DF_STORES
#undef DF_SOFTMAX_PV
    l = xhalf_sum(l);
    const float inv = 1.0f / l;
    LAS float* xb = (LAS float*)F.lds + wq * 4096;
    if (c == 1) {
        const float sc = lam * inv;
#pragma unroll
        for (int dt = 0; dt < 4; ++dt)
#pragma unroll
            for (int i = 0; i < 16; ++i) xb[(dt * 16 + i) * 64 + lane] = o[dt][i] * sc;
    }
    __syncthreads();
    if (c == 0) {
        float ss = 0.f;
#pragma unroll
        for (int dt = 0; dt < 4; ++dt)
#pragma unroll
            for (int i = 0; i < 16; ++i) { const float v = o[dt][i] * inv - xb[(dt * 16 + i) * 64 + lane]; o[dt][i] = v; ss += v * v; }
        ss += __shfl_xor(ss, 32);
        const float rs = rsqrtf(ss * (1.f / 128.f) + NORM_EPS) * 0.8f;
        bf16_t* yrow = F.YA + ((size_t)b * SEQ + qpos) * 1024 + h * 128;
#pragma unroll
        for (int dt = 0; dt < 4; ++dt)
#pragma unroll
            for (int ap = 0; ap < 4; ap += 2) { u32x2 w[2];
#pragma unroll
                for (int q = 0; q < 2; ++q) { const int a = ap + q; const int dv = 32 * dt + 8 * a + 4 * hi; const f32x4 g = *(const f32x4*)(F.subln + dv);
                    w[q].x = pk2(o[dt][4 * a] * rs * g[0], o[dt][4 * a + 1] * rs * g[1]); w[q].y = pk2(o[dt][4 * a + 2] * rs * g[2], o[dt][4 * a + 3] * rs * g[3]); }
                *(u32x4*)(yrow + 32 * dt + 8 * ap + 8 * hi) = pair_swap16(w[0], w[1]); }
    }
    __syncthreads();
}

DI void cmp_gemm2(Frame& F, int c) {
    const int kv = c >> 3, m0 = (c & 7) * 256, tid = F.tid;
    __syncthreads();
    LAS float* w2s = (LAS float*)F.lds;
    for (int i = tid; i < 256 * 64 / 4; i += NTHREADS) *((LAS f32x4*)w2s + i) = *((const f32x4*)(F.cw2 + (size_t)kv * 256 * 64) + i);
    __syncthreads();
    const int qd = tid & 3;
#pragma unroll 1
    for (int pass = 0; pass < 2; ++pass) {
        const int m = m0 + pass * 128 + (tid >> 2);
        const bf16_t* hr = F.HID + ((size_t)kv * 2048 + m) * 256;
        float acc[16];
#pragma unroll
        for (int n = 0; n < 16; ++n) acc[n] = 0.f;
#pragma unroll 1
        for (int k8 = 0; k8 < 32; ++k8) {
            const u32x4 w = *(const u32x4*)(hr + k8 * 8);
            const float a[8] = {bflo(w.x), bfhi(w.x), bflo(w.y), bfhi(w.y), bflo(w.z), bfhi(w.z), bflo(w.w), bfhi(w.w)};
#pragma unroll
            for (int kk = 0; kk < 8; ++kk) {
                const LAS f32x4* wr = (const LAS f32x4*)(w2s + (k8 * 8 + kk) * 64 + qd * 16);
#pragma unroll
                for (int n4 = 0; n4 < 4; ++n4) { const f32x4 wv = wr[n4]; acc[4 * n4] += a[kk] * wv[0]; acc[4 * n4 + 1] += a[kk] * wv[1]; acc[4 * n4 + 2] += a[kk] * wv[2]; acc[4 * n4 + 3] += a[kk] * wv[3]; }
            }
        }
        if (kv == 0) {
            float ss = 0.f;
#pragma unroll
            for (int n = 0; n < 16; ++n) ss += acc[n] * acc[n];
            ss += __shfl_xor(ss, 1); ss += __shfl_xor(ss, 2);
            const float rs = rsqrtf(ss * (1.f / 64.f) + NORM_EPS);
#pragma unroll
            for (int n = 0; n < 16; ++n) acc[n] *= rs * F.nkn[qd * 16 + n];
        }
        const bool padrow = (m & 255) == 255;
        bf16_t* orow = (kv ? F.VC : F.KC) + (size_t)m * 64 + qd * 16;
#pragma unroll
        for (int n8 = 0; n8 < 2; ++n8) { u32x4 o; o.x = pk2(acc[8 * n8], acc[8 * n8 + 1]); o.y = pk2(acc[8 * n8 + 2], acc[8 * n8 + 3]); o.z = pk2(acc[8 * n8 + 4], acc[8 * n8 + 5]); o.w = pk2(acc[8 * n8 + 6], acc[8 * n8 + 7]);
            if (padrow) o = (u32x4){0u, 0u, 0u, 0u};
            *(u32x4*)(orow + n8 * 8) = o; }
    }
    __syncthreads();
}

constexpr int NS_BUF = 64 * KP + 64 * 192;
constexpr int NS_SLAB = 2 * NS_BUF;
constexpr int NS_SELM = NS_SLAB + 8 * 32 * 65 * 4;
template <int BR> DI void nsa_branch(Frame& F, unsigned long long tiles, const bf16_t* kptr, size_t kpitch, const bf16_t* vptr, size_t vpitch,
                                     const bf16x8* qf, float& m, float& l, f32x16* o, int qpos, unsigned long long mymask, float inv_l, float soff) {
    const int tid = F.tid, lane = F.lane, r32 = lane & 31, hi = lane >> 5;
    const int row = tid >> 3, ch = tid & 7;
    if (tiles == 0ull) return;
    u32x4 rk, rv;
    unsigned long long rest = tiles;
    int kt = __builtin_ctzll(rest); rest &= rest - 1;
    rk = *(const u32x4*)(kptr + ((size_t)kt * 64 + row) * kpitch + ch * 8); rv = *(const u32x4*)(vptr + ((size_t)kt * 64 + row) * vpitch + ch * 8);
    int buf = 0;
    { LAS unsigned char* bb = F.lds; *(LAS u32x4*)(bb + row * KP + ch * 16) = rk; *(LAS u32x4*)(bb + 64 * KP + row * 192 + ch * 16) = rv; }
    __syncthreads();
    for (;;) {
        const bool more = rest != 0ull;
        int ktn = 0;
        if (more) { ktn = __builtin_ctzll(rest); rest &= rest - 1;
            rk = *(const u32x4*)(kptr + ((size_t)ktn * 64 + row) * kpitch + ch * 8); rv = *(const u32x4*)(vptr + ((size_t)ktn * 64 + row) * vpitch + ch * 8); }
        const LAS unsigned char* bb = F.lds + buf * NS_BUF;
        f32x16 s0, s1;
        const bool selbit = BR == 2 ? ((mymask >> kt) & 1ull) != 0ull : true;
        qk_tile(s0, s1, bb, qf, r32, hi, selbit ? soff : -INFINITY);
        const int t0 = qpos - r32;
        bool full;
        if (BR <= 1) full = 16 * (64 * kt + 63) + 31 <= t0;
        else if (BR == 2) full = 64 * kt + 63 <= t0;
        else full = (64 * kt + 63 <= t0) && (t0 + 31 - 64 * kt < 512);
        if (!full) {
#pragma unroll
            for (int i = 0; i < 16; ++i) {
                const int k0 = 64 * kt + crow(i, hi), k1 = k0 + 32;
                bool v0, v1;
                if (BR <= 1) { v0 = 16 * k0 + 31 <= qpos; v1 = 16 * k1 + 31 <= qpos; }
                else if (BR == 2) { v0 = k0 <= qpos; v1 = k1 <= qpos; }
                else { const int d0 = qpos - k0, d1 = qpos - k1; v0 = d0 >= 0 && d0 < 512; v1 = d1 >= 0 && d1 < 512; }
                s0[i] = v0 ? s0[i] : -INFINITY; s1[i] = v1 ? s1[i] : -INFINITY;
            }
        }
        if (BR == 0) {
            f32x16* none = nullptr;
            online_step<0>(s0, s1, m, l, none, true);
        } else if (BR == 1) {
            online_step<2>(s0, s1, m, l, o, true);
            LAS float* slab = (LAS float*)(F.lds + NS_SLAB) + F.wave * (32 * 65) + r32 * 65;
#pragma unroll
            for (int t = 0; t < 2; ++t)
#pragma unroll
                for (int a = 0; a < 4; ++a) {
                    const f32x16& s = t ? s1 : s0;
                    const int J = 16 * kt + 8 * t + 2 * a + hi;
                    const float gsum = (s[4 * a] + s[4 * a + 1]) + (s[4 * a + 2] + s[4 * a + 3]);
                    atomicAdd((float*)(slab + J), gsum);
                    atomicAdd((float*)(slab + J + 1), s[4 * a + 3]);
                }
            pv_tile<2, 192>(o, bb + 64 * KP, s0, s1, lane);
        } else {
            softmax_pv<2, 192, false>(s0, s1, l, o, bb + 64 * KP, lane, 0.f);
        }
        if (more) { LAS unsigned char* nb = F.lds + (buf ^ 1) * NS_BUF; *(LAS u32x4*)(nb + row * KP + ch * 16) = rk; *(LAS u32x4*)(nb + 64 * KP + row * 192 + ch * 16) = rv; }
        __syncthreads();
        if (!more) break;
        kt = ktn; buf ^= 1;
    }
}
DI void nsa_unit(Frame& F, int b, int g, int tt, float soff) {
    const int lane = F.lane, wid = F.wave, r32 = lane & 31, hi = lane >> 5;
    const int t0 = tt * 32, qpos = t0 + r32, hn = g * 8 + wid, qblk = t0 >> 6;
    const size_t tok = (size_t)b * SEQ + qpos;
    const bf16_t* zb = F.Z + (size_t)b * SEQ * LDZ;
    const bf16_t* zr = F.Z + tok * LDZ;
    bf16x8 qf[4], qp0;
    { const bf16_t* qrow = zr + ZC_NQ + hn * 64 + hi * 8;
#pragma unroll
      for (int cc = 0; cc < 4; ++cc) qf[cc] = *(const bf16x8*)(qrow + cc * 16);
      qp0 = *(const bf16x8*)(F.QP + (tok * 16 + hn) * 16 + hi * 8); }
    const float g0 = sigmoidf_(bf2f(zr[ZC_NG + hn * 3 + 0])), g1 = sigmoidf_(bf2f(zr[ZC_NG + hn * 3 + 1])), g2 = sigmoidf_(bf2f(zr[ZC_NG + hn * 3 + 2]));
    f32x16 o[2];
#pragma unroll
    for (int dt = 0; dt < 2; ++dt) for (int i = 0; i < 16; ++i) o[dt][i] = 0.f;
    LAS f32x4* stg = (LAS f32x4*)(F.lds + NS_SLAB + wid * 8192) + lane;
    { LAS float* slab = (LAS float*)(F.lds + NS_SLAB) + wid * (32 * 65);
      for (int i = lane; i < 32 * 65; i += 64) slab[i] = 0.f; }
    const int ncb = min(t0 / 16 + 1, 255), nct = (ncb + 63) >> 6;
    const unsigned long long ctiles = (1ull << nct) - 1ull;
    const bf16_t* kc = F.KC + (size_t)(b * 2 + g) * 256 * 64; const bf16_t* vc = F.VC + (size_t)(b * 2 + g) * 256 * 64;
    {
        bf16x8 qpl[4] = {qp0, qf[1], qf[2], qf[3]};
        float m = -INFINITY, l = 0.f;
        nsa_branch<1>(F, ctiles, kc, 64, vc, 64, qpl, m, l, o, qpos, 0ull, 0.f, soff);
        l = xhalf_sum(l);
        const float inv = l > 0.f ? 1.0f / l : 0.f;
#pragma unroll
        for (int dt = 0; dt < 2; ++dt) for (int i = 0; i < 16; ++i) o[dt][i] *= inv;
        if (lane < 32) ((LAS float*)(F.lds + NS_SELM + 256))[wid * 32 + lane] = inv;
    }
    __syncthreads();
    {
        const LAS float* slabs = (const LAS float*)(F.lds + NS_SLAB);
        LAS unsigned long long* selm = (LAS unsigned long long*)(F.lds + NS_SELM);
#pragma unroll 1
        for (int tk = 0; tk < 4; ++tk) {
            const int token = 4 * wid + tk, j = lane;
            float v = 0.f;
#pragma unroll
            for (int w = 0; w < 8; ++w) v += slabs[w * (32 * 65) + token * 65 + j] * ((const LAS float*)(F.lds + NS_SELM + 256))[w * 32 + token];
            const bool valid = j <= qblk, forced = (j == 0) || (j == qblk) || (j == qblk - 1);
            const float score = valid ? v + (forced ? 1e4f : 0.f) : -1.0f;
            int rank = 0;
#pragma unroll
            for (int jj = 0; jj < 64; ++jj) { const float so = __builtin_bit_cast(float, __builtin_amdgcn_readlane(__builtin_bit_cast(int, score), jj));
                rank += (so > score || (so == score && jj < j)) ? 1 : 0; }
            const unsigned long long msk = __ballot(rank < 16);
            if (lane == 0) selm[token] = msk;
        }
    }
    __syncthreads();
    unsigned long long mymask, uni = 0ull;
    { const LAS unsigned long long* selm = (const LAS unsigned long long*)(F.lds + NS_SELM);
      mymask = selm[r32];
      unsigned long long u = mymask;
#pragma unroll
      for (int of = 1; of < 32; of <<= 1) { const unsigned lo = __shfl_xor((unsigned)u, of), hh = __shfl_xor((unsigned)(u >> 32), of); u |= ((unsigned long long)hh << 32) | lo; }
      const unsigned ulo = __builtin_amdgcn_readfirstlane((unsigned)u), uhi = __builtin_amdgcn_readfirstlane((unsigned)(u >> 32));
      uni = ((unsigned long long)uhi << 32) | ulo; }
    const unsigned long long validm = (qblk >= 63) ? ~0ull : ((1ull << (qblk + 1)) - 1ull);
#pragma unroll
    for (int dt = 0; dt < 2; ++dt)
#pragma unroll
        for (int a = 0; a < 4; ++a) { stg[(dt * 4 + a) * 64] = (f32x4){g0 * o[dt][4 * a], g0 * o[dt][4 * a + 1], g0 * o[dt][4 * a + 2], g0 * o[dt][4 * a + 3]};
            o[dt][4 * a] = 0.f; o[dt][4 * a + 1] = 0.f; o[dt][4 * a + 2] = 0.f; o[dt][4 * a + 3] = 0.f; }
    {
        float m = -INFINITY, l = 0.f;
        nsa_branch<2>(F, uni & validm, F.NKV + (size_t)(0 * 8 + b * 2 + g) * SEQ * 64, 64, F.NKV + (size_t)(1 * 8 + b * 2 + g) * SEQ * 64, 64, qf, m, l, o, qpos, mymask, 0.f, soff);
        l = xhalf_sum(l);
        const float sc = l > 0.f ? g1 / l : 0.f;
#pragma unroll
        for (int dt = 0; dt < 2; ++dt)
#pragma unroll
            for (int a = 0; a < 4; ++a) { f32x4 v = stg[(dt * 4 + a) * 64];
                v[0] += sc * o[dt][4 * a]; v[1] += sc * o[dt][4 * a + 1]; v[2] += sc * o[dt][4 * a + 2]; v[3] += sc * o[dt][4 * a + 3]; stg[(dt * 4 + a) * 64] = v;
                o[dt][4 * a] = 0.f; o[dt][4 * a + 1] = 0.f; o[dt][4 * a + 2] = 0.f; o[dt][4 * a + 3] = 0.f; }
    }
    {
        const int lo_key = max(0, t0 - 511), kt_lo = lo_key >> 6, kt_hi = (t0 + 31) >> 6;
        const unsigned long long hm = (kt_hi >= 63) ? ~0ull : ((1ull << (kt_hi + 1)) - 1ull);
        const unsigned long long wtiles = hm & ~((1ull << kt_lo) - 1ull);
        float m = -INFINITY, l = 0.f;
        nsa_branch<3>(F, wtiles, F.NKV + (size_t)(2 * 8 + b * 2 + g) * SEQ * 64, 64, F.NKV + (size_t)(3 * 8 + b * 2 + g) * SEQ * 64, 64, qf, m, l, o, qpos, 0ull, 0.f, soff);
        l = xhalf_sum(l);
        const float sc = l > 0.f ? g2 / l : 0.f;
#pragma unroll
        for (int dt = 0; dt < 2; ++dt)
#pragma unroll
            for (int a = 0; a < 4; ++a) { const f32x4 v = stg[(dt * 4 + a) * 64];
                o[dt][4 * a] = v[0] + sc * o[dt][4 * a]; o[dt][4 * a + 1] = v[1] + sc * o[dt][4 * a + 1]; o[dt][4 * a + 2] = v[2] + sc * o[dt][4 * a + 2]; o[dt][4 * a + 3] = v[3] + sc * o[dt][4 * a + 3]; }
    }
    bf16_t* yrow = F.YB + tok * 1024 + hn * 64;
#pragma unroll
    for (int dt = 0; dt < 2; ++dt)
#pragma unroll
        for (int ap = 0; ap < 4; ap += 2) { u32x2 w[2];
#pragma unroll
            for (int q = 0; q < 2; ++q) { const int a = ap + q; w[q].x = pk2(o[dt][4 * a], o[dt][4 * a + 1]); w[q].y = pk2(o[dt][4 * a + 2], o[dt][4 * a + 3]); }
            *(u32x4*)(yrow + 32 * dt + 8 * ap + 8 * hi) = pair_swap16(w[0], w[1]); }
    __syncthreads();
}

DI void mk_frame(Frame& F, const Params& prm, unsigned char* lds_raw_) {
    F.lds = (LAS unsigned char*)lds_raw_;
    F.tid = threadIdx.x; F.lane = F.tid & 63; F.wave = __builtin_amdgcn_readfirstlane(F.tid >> 6);
    F.G = gridDim.x; F.bid = blockIdx.x; F.vcu = (F.G % 8 == 0) ? (F.bid % 8) * (F.G / 8) + F.bid / 8 : F.bid;
    F.x = prm.in[0]; F.p = prm.in[1]; F.pos = (const int*)prm.in[2]; F.norm_mix = prm.in[3]; F.w_in = prm.in[4]; F.dqn = prm.in[5]; F.dkn = prm.in[6];
    F.dlam = prm.in[7]; F.subln = prm.in[8]; F.nqn = prm.in[9]; F.nkn = prm.in[10]; F.cpos = prm.in[11]; F.cw1 = prm.in[12]; F.cw2 = prm.in[13];
    F.wpd = prm.in[14]; F.wpn = prm.in[15]; F.wout = prm.in[16]; F.norm_mlp = prm.in[17]; F.wup = prm.in[18]; F.wdn = prm.in[19]; F.wple = prm.in[20];
    F.norm_ple = prm.in[21]; F.wgate = prm.in[22]; F.out = prm.out;
    unsigned char* ws = prm.ws; unsigned char* dob = (unsigned char*)prm.out;
    F.WIN = (bf16_t*)(ws + WS_WIN); F.WUP = (bf16_t*)(ws + WS_WUP); F.WDN = (bf16_t*)(ws + WS_WDN); F.WOUT = (bf16_t*)(ws + WS_WOUT); F.WGATE = (bf16_t*)(ws + WS_WGATE);
    F.WPD = (bf16_t*)(ws + WS_WPD); F.WPN = (bf16_t*)(ws + WS_WPN); F.WPLE = (bf16_t*)(ws + WS_WPLE); F.WC1 = (bf16_t*)(ws + WS_WC1);
    F.H = (bf16_t*)(ws + WS_H); F.Z = (bf16_t*)(ws + WS_Z); F.PE = (bf16_t*)(ws + WS_PE); F.PB = (bf16_t*)(ws + WS_PB); F.X1B = (bf16_t*)(ws + WS_X1B); F.HIDN = (bf16_t*)(ws + WS_HID);
    F.SSQ1 = (float*)(ws + WS_SSQ); F.SSQ2 = F.SSQ1 + T; F.SSQPE = F.SSQ1 + 2 * T;
    F.YA = (bf16_t*)(dob + DO_YA); F.YB = (bf16_t*)(dob + DO_YB); F.BLK = (bf16_t*)(dob + DO_BLK); F.HID = (bf16_t*)(dob + DO_HID); F.KC = (bf16_t*)(dob + DO_KC);
    F.VC = (bf16_t*)(dob + DO_VC); F.QP = (bf16_t*)(dob + DO_QP); F.ROPE = (float*)(dob + DO_ROPE);
    F.KD = (bf16_t*)(dob + DO_KD); F.VD = (bf16_t*)(ws + WS_H); F.NKV = (bf16_t*)(ws + WS_H + 32 * MiB);
}
#define XB_TMO      128
#define XB_XCNT(j)  (256  + 64 * (j))
#define XB_XSUB(j)  (1280 + 64 * (j))
#define XB_XGEN(j)  (2304 + 64 * (j))
#define XB_TOP      3328
#define XB_TOPGEN   3392
#define XCD_BAR_WORDS 3456
#define XB_SPIN_CAP (1u << 18)

__device__ __forceinline__ unsigned xb_ld(unsigned* p)              { return __hip_atomic_load(p, __ATOMIC_RELAXED, __HIP_MEMORY_SCOPE_AGENT); }
__device__ __forceinline__ unsigned xb_add(unsigned* p, unsigned v) { return __hip_atomic_fetch_add(p, v, __ATOMIC_RELAXED, __HIP_MEMORY_SCOPE_AGENT); }
__device__ __forceinline__ unsigned xb_xcc_id() { return (unsigned)__builtin_amdgcn_s_getreg((3 << 11) | 20) & 0xFu; }
#define XB_SPIN(cond, bar) do { unsigned _sp = 0; while (cond) { __builtin_amdgcn_s_sleep(1); \
    if ((++_sp & 255u) == 0u) { if (xb_ld(&(bar)[XB_TMO])) break; if (_sp > XB_SPIN_CAP) { atomicAdd(&(bar)[XB_TMO], 1u); break; } } } } while (0)

struct XcdBarrier {
    unsigned* bar; unsigned x;
    volatile LAS unsigned* st;
};

__device__ __forceinline__ XcdBarrier xcd_barrier_post(unsigned* bar, volatile LAS unsigned* st) {
    XcdBarrier b; b.bar = bar; b.x = xb_xcc_id(); b.st = st;
    if (threadIdx.x == 0) (void)xb_add(&bar[XB_XCNT(b.x)], 1u);
    return b;
}
__device__ __forceinline__ void xcd_barrier_complete(unsigned* bar, unsigned x, unsigned& nloc, unsigned& nx) {
    const unsigned G = gridDim.x * gridDim.y * gridDim.z;
    unsigned sum, cnt, mine, sp = 0u;
    for (;;) {
        sum = 0u; cnt = 0u; mine = 0u;
#pragma unroll
        for (unsigned j = 0; j < 16; ++j) { const unsigned c = xb_ld(&bar[XB_XCNT(j)]); sum += c; cnt += (c > 0u) ? 1u : 0u; mine = (j == x) ? c : mine; }
        if (sum == G) break;
        __builtin_amdgcn_s_sleep(1);
        if ((++sp & 255u) == 0u) { if (xb_ld(&bar[XB_TMO])) break; if (sp > XB_SPIN_CAP) { atomicAdd(&bar[XB_TMO], 1u); break; } }
    }
    nloc = mine > 0u ? mine : 1u; nx = cnt > 0u ? cnt : 1u;
}

__device__ __forceinline__ void xcd_barrier(const XcdBarrier& b) {
    asm volatile("s_waitcnt vmcnt(0)" ::: "memory");
    __syncthreads();
    if (threadIdx.x == 0) {
        unsigned* bar = b.bar;
        __builtin_amdgcn_s_waitcnt(0);
        unsigned nloc = b.st[0], nx = b.st[1];
        if (nloc == 0u) { xcd_barrier_complete(bar, b.x, nloc, nx); b.st[0] = nloc; b.st[1] = nx; }
        const unsigned old = xb_add(&bar[XB_XSUB(b.x)], 1u);
        const unsigned gen = old / nloc;
        if (old + 1u == (gen + 1u) * nloc) {
            __builtin_amdgcn_fence(__ATOMIC_RELEASE, "agent");
            asm volatile("s_waitcnt vmcnt(0)" ::: "memory");
            const unsigned og = xb_add(&bar[XB_TOP], 1u);
            const unsigned tg = og / nx;
            if (og + 1u == (tg + 1u) * nx) xb_add(&bar[XB_TOPGEN], 1u);
            else XB_SPIN(xb_ld(&bar[XB_TOPGEN]) == tg, bar);
            __builtin_amdgcn_fence(__ATOMIC_ACQUIRE, "agent");
            xb_add(&bar[XB_XGEN(b.x)], 1u);
            asm volatile("s_waitcnt vmcnt(0)" ::: "memory");
        } else {
            XB_SPIN(xb_ld(&bar[XB_XGEN(b.x)]) == gen, bar);
            __builtin_amdgcn_fence(__ATOMIC_ACQUIRE, "agent");
            asm volatile("s_waitcnt vmcnt(0)" ::: "memory");
        }
    }
    __syncthreads();
}


constexpr int NPHASE = 11;
#ifndef REP_MASK
#define REP_MASK 0
#endif
__global__ void __launch_bounds__(NTHREADS, 2) fwd_megakernel(Params prm, int ph_lo, int ph_hi) {
    extern __shared__ __attribute__((aligned(16))) unsigned char lds_raw[];
    cg::grid_group grid = cg::this_grid();
    for (int u = threadIdx.x; u < (LDS_BYTES - LDSCTL_OFF) / 4; u += NTHREADS) ((LAS unsigned*)((LAS unsigned char*)lds_raw + LDSCTL_OFF))[u] = 0u;
    __syncthreads();
    XcdBarrier xbar = xcd_barrier_post((unsigned*)(prm.ws + WS_CTL), (volatile LAS unsigned*)((LAS unsigned char*)lds_raw + MISC_OFF) + 8);
#define IN(k) (ph_lo <= (k) && (k) < ph_hi)
#define REP(k) for (int rep_ = 0; rep_ < (((REP_MASK) >> (k)) & 1) + 1; ++rep_)
#ifndef SYNC_REP
#define SYNC_REP 1
#endif
#define SEAM(k) do { if (IN(k) && IN((k) + 1)) { for (int sr_ = 0; sr_ < SYNC_REP; ++sr_) { if (ph_lo < 0) grid.sync(); else xcd_barrier(xbar); } } } while (0)
#define FRAME Frame F; mk_frame(F, prm, lds_raw); const int gw = F.vcu * NWAVES + F.wave, NGW = F.G * NWAVES; (void)gw; (void)NGW

    if (IN(0)) REP(0) { FRAME; p0_prologue(F); }
    SEAM(0);
    if (IN(1)) REP(1) { FRAME;
        pg8::Gemm g{F.H, F.WIN, T, LDZ, DM}; pg8::StaticOrder S; S.init(T, LDZ, F.G, F.bid);
        pg8::EpiBf16<0, false> E{F.Z, LDZ, nullptr, nullptr};
        pg8::gemm_phase<pg8::EpiBf16<0, false>, pg8::StaticOrder, true, true>(F.lds, g, S, E);
    }
    SEAM(1);
    if (IN(2)) { FRAME; p2a_blocks(F); }
    SEAM(2);
    if (IN(3)) { FRAME;
        if (F.G > 32) {
            if (F.bid < 16) {
                pg8::Gemm g{F.BLK, F.WC1, 4096, 256, 2048}; pg8::CmpOrder S{F.bid};
                pg8::EpiBf16<2, true> E{F.HID, 256, nullptr, nullptr};
                pg8::gemm_phase<pg8::EpiBf16<2, true>, pg8::CmpOrder, false, true>(F.lds, g, S, E);
                cmp_gemm2(F, F.bid);
            } else {
                p2_postprocess(F, (F.bid - 16) * NWAVES + F.wave, (F.G - 16) * NWAVES);
            }
        } else {
            for (int c = F.bid; c < 16; c += F.G) {
                pg8::Gemm g{F.BLK, F.WC1, 4096, 256, 2048}; pg8::CmpOrder S{c};
                pg8::EpiBf16<2, true> E{F.HID, 256, nullptr, nullptr};
                pg8::gemm_phase<pg8::EpiBf16<2, true>, pg8::CmpOrder, false, true>(F.lds, g, S, E);
                cmp_gemm2(F, c);
            }
            p2_postprocess(F, F.bid * NWAVES + F.wave, NGW);
        }
    }
    SEAM(3);
    if (IN(4)) { FRAME;
        float lam;
        { const float a = F.dlam[F.lane] * F.dlam[64 + F.lane], bq = F.dlam[128 + F.lane] * F.dlam[192 + F.lane];
          lam = __expf(wave_sum(a)) - __expf(wave_sum(bq)) + 0.2f; }
        float soff;
        { float gq = fabsf(F.dqn[F.lane]), gk = fabsf(F.dkn[F.lane]);
#pragma unroll
          for (int of = 1; of < 64; of <<= 1) { gq = fmaxf(gq, __shfl_xor(gq, of)); gk = fmaxf(gk, __shfl_xor(gk, of)); }
          const float bnd = 64.f * SC_L2E * gq * gk; soff = bnd > 100.f ? 60.f - bnd : 0.f; }
        for (int i = F.vcu; i < 1024 * (((REP_MASK >> 4) & 1) + 1); i += F.G) {
            const int c = i & 255, round = (i >> 8) & 3, j = c & 31, bh = (c >> 5) * 4 + round;
            const int qt = (round & 1) ? j : 31 - j;
            diff_unit(F, bh >> 3, bh & 7, qt, lam, soff);
        }
    }
    if (IN(5)) { FRAME;
        float soff;
        { float gq = fabsf(F.nqn[F.lane]), gk = fabsf(F.nkn[F.lane]);
#pragma unroll
          for (int of = 1; of < 64; of <<= 1) { gq = fmaxf(gq, __shfl_xor(gq, of)); gk = fmaxf(gk, __shfl_xor(gk, of)); }
          const float bnd = 64.f * SC_L2E * gq * gk; soff = bnd > 100.f ? 60.f - bnd : 0.f; }
        for (int i = F.vcu; i < 1024 * (((REP_MASK >> 5) & 1) + 1); i += F.G) {
            const int c = i & 255, round = (i >> 8) & 3, s = c & 31, bg = c >> 5;
            const int tt = round == 0 ? 127 - s : round == 1 ? 64 + s : round == 2 ? 63 - s : s;
            nsa_unit(F, bg >> 1, bg & 1, tt, soff);
        }
    }
    SEAM(5);
    if (IN(6)) REP(6) { FRAME;
        { pg8::Gemm g{F.YA, F.WPD, T, DM, 1024}; pg8::StaticOrder S; S.init(T, DM, F.G, F.bid);
          pg8::EpiGate<false> E{F.H, DM, F.Z + ZC_GA, LDZ};
          pg8::gemm_phase<pg8::EpiGate<false>, pg8::StaticOrder, true, true>(F.lds, g, S, E); }
        { pg8::Gemm g{F.YB, F.WPN, T, DM, 1024}; pg8::StaticOrder S; S.init(T, DM, F.G, F.bid);
          pg8::EpiGate<true> E{F.H, DM, F.Z + ZC_GB, LDZ};
          pg8::gemm_phase<pg8::EpiGate<true>, pg8::StaticOrder, true, true>(F.lds, g, S, E); }
    }
    SEAM(6);
    if (IN(7)) { FRAME;
        for (int e = gw * 64 + F.lane; e < T * PLE / 8; e += NGW * 64) {
            const f32x4 a = *((const f32x4*)F.p + 2 * e), bq = *((const f32x4*)F.p + 2 * e + 1);
            u32x4 o; o.x = pk2(a[0], a[1]); o.y = pk2(a[2], a[3]); o.z = pk2(bq[0], bq[1]); o.w = pk2(bq[2], bq[3]);
            *((u32x4*)F.PB + e) = o;
        }
        pg8::Gemm g{F.H, F.WOUT, T, DM, DM}; pg8::StaticOrder S; S.init(T, DM, F.G, F.bid);
        pg8::EpiRes E{F.x, F.out, DM, F.X1B, F.SSQ1};
        pg8::gemm_phase<pg8::EpiRes, pg8::StaticOrder, true, true>(F.lds, g, S, E);
    }
    SEAM(7);
    if (IN(8)) REP(8) { FRAME;
        pg8::Gemm g{F.X1B, F.WUP, T, DFF, DM}; pg8::StaticOrder S; S.init(T, DFF, F.G, F.bid);
        pg8::EpiBf16<1, false, true, false> E{F.HIDN, DFF, F.SSQ1, nullptr};
        pg8::gemm_phase<pg8::EpiBf16<1, false, true, false>, pg8::StaticOrder, true, true>(F.lds, g, S, E);
    }
    SEAM(8);
    if (IN(9)) { FRAME;
        { pg8::Gemm g{F.HIDN, F.WDN, T, DM, DFF}; pg8::StaticOrder S; S.init(T, DM, F.G, F.bid);
          pg8::EpiRes E{F.out, F.out, DM, F.H, F.SSQ2};
          pg8::gemm_phase<pg8::EpiRes, pg8::StaticOrder, true, true>(F.lds, g, S, E); }
        { pg8::Gemm g{F.PB, F.WPLE, T, DM, PLE}; pg8::StaticOrder S; S.init(T, DM, F.G, F.bid);
          pg8::EpiBf16<0, false, false, true> E{F.PE, DM, nullptr, F.SSQPE};
          pg8::gemm_phase<pg8::EpiBf16<0, false, false, true>, pg8::StaticOrder, true, true>(F.lds, g, S, E); }
    }
    SEAM(9);
    if (IN(10)) { FRAME;
        pg8::Gemm g{F.H, F.WGATE, T, DM, DM}; pg8::StaticOrder S; S.init(T, DM, F.G, F.bid);
        pg8::EpiFinal E{F.out, F.out, DM, F.PE, F.SSQ2, F.SSQPE, F.norm_ple};
        pg8::gemm_phase<pg8::EpiFinal, pg8::StaticOrder, true, true>(F.lds, g, S, E);
    }
#undef IN
#undef SEAM
#undef REP
#undef FRAME
}

#ifndef MK_PER_PHASE
#define MK_PER_PHASE 0
#endif
extern "C" void kernel_launch(void* const* d_in, const int* in_sizes, int n_in, void* d_out, int out_size, void* d_ws, size_t ws_size, hipStream_t stream) {
    static int grid = 0;
    if (grid == 0) {
        if (n_in != 23 || in_sizes[0] != T * DM || out_size != T * DM || ws_size < WS_END) {
            fprintf(stderr, "kernel_launch: unexpected shapes (n_in %d, in0 %d, out %d, ws %zu); nothing launched\n", n_in, n_in > 0 ? in_sizes[0] : -1, out_size, ws_size); grid = -1; return; }
        int dev = 0, cus = 0, per_cu = 0;
        hipGetDevice(&dev); hipDeviceGetAttribute(&cus, hipDeviceAttributeMultiprocessorCount, dev);
        if (hipFuncSetAttribute((const void*)fwd_megakernel, hipFuncAttributeMaxDynamicSharedMemorySize, LDS_BYTES) != hipSuccess) { fprintf(stderr, "kernel_launch: hipFuncSetAttribute failed\n"); grid = -1; return; }
        if (hipOccupancyMaxActiveBlocksPerMultiprocessor(&per_cu, (const void*)fwd_megakernel, NTHREADS, LDS_BYTES) != hipSuccess || per_cu < 1) { fprintf(stderr, "kernel_launch: occupancy query gives %d\n", per_cu); per_cu = 1; }
        (void)hipGetLastError();
        grid = cus * per_cu;
    }
    if (grid < 0) return;
    if (hipMemsetAsync((char*)d_ws + WS_CTL, 0, CTL_ZERO_BYTES, stream) != hipSuccess) { fprintf(stderr, "kernel_launch: hipMemsetAsync failed\n"); return; }
    Params prm{};
    for (int i = 0; i < 23; ++i) prm.in[i] = (const float*)d_in[i];
    prm.out = (float*)d_out; prm.ws = (unsigned char*)d_ws;
#if MK_PER_PHASE
    for (int ph = 0; ph < NPHASE; ++ph) { int lo = ph, hi = ph + 1; void* args[] = {&prm, &lo, &hi};
        hipLaunchCooperativeKernel((const void*)fwd_megakernel, dim3(grid), dim3(NTHREADS), args, LDS_BYTES, stream); }
#else
    int lo = 0, hi = NPHASE; void* args[] = {&prm, &lo, &hi};
    hipError_t e = hipLaunchCooperativeKernel((const void*)fwd_megakernel, dim3(grid), dim3(NTHREADS), args, LDS_BYTES, stream);
    if (e != hipSuccess) fprintf(stderr, "kernel_launch: cooperative launch failed: %s (grid %d)\n", hipGetErrorString(e), grid);
#endif
}
```
